# Optimizing an MI355X kernel written in HIP

```python
import math
import jax, jax.numpy as jnp
from jax import lax
import numpy as np

D_MODEL = 1024
BATCH = 16
SEQ = 2048
DEPTH = 1

N_Q_HEADS = 8
N_KV_HEADS = 2
HEAD_DIM = 64
WINDOW = 128
BLOCK = 128
ATT_WIDTH = N_Q_HEADS * HEAD_DIM
KV_WIDTH = N_KV_HEADS * HEAD_DIM
GLA_HEADS = 4
GLA_DK = 64
GLA_DV = 128
GLA_K_WIDTH = GLA_HEADS * GLA_DK
GLA_V_WIDTH = GLA_HEADS * GLA_DV
GLA_GATE_RANK = 16
GLA_TAU = 16.0
GLA_CHUNK = 64
REL_BUCKETS = 32
REL_MAX_DIST = 128
D_FF = 2816
EPS = 1e-6
IN_SPLITS = (ATT_WIDTH, KV_WIDTH, KV_WIDTH, GLA_K_WIDTH, GLA_K_WIDTH, GLA_V_WIDTH, GLA_V_WIDTH, GLA_GATE_RANK, D_MODEL, D_MODEL)
IN_WIDTH = sum(IN_SPLITS)

kernel_name = "hybrid_swa_sink_gla_macaron_block"


def rmsnorm(x, g):
    x32 = x.astype(jnp.float32)
    y = x32 * lax.rsqrt(jnp.mean(x32 * x32, axis=-1, keepdims=True) + EPS)
    return (y * g.astype(jnp.float32)).astype(x.dtype)


def swiglu(x, w_gate, w_up, w_down):
    return (jax.nn.silu(x @ w_gate) * (x @ w_up)) @ w_down


def t5_causal_bucket(dist):
    n = jnp.clip(dist, 0, REL_MAX_DIST - 1)
    max_exact = REL_BUCKETS // 2
    nf = jnp.maximum(n, 1).astype(jnp.float32)
    large = max_exact + (jnp.log(nf / max_exact) / math.log(REL_MAX_DIST / max_exact)
                         * (REL_BUCKETS - max_exact)).astype(jnp.int32)
    large = jnp.minimum(large, REL_BUCKETS - 1)
    return jnp.where(n < max_exact, n, large)


def sliding_window_attention(q, k, v, sinks, rel_table):
    B, S = q.shape[0], q.shape[1]
    nb = S // BLOCK
    G = N_Q_HEADS // N_KV_HEADS
    qb = q.reshape(B, nb, BLOCK, N_KV_HEADS, G, HEAD_DIM)

    def band(t):
        tb = t.reshape(B, nb, BLOCK, N_KV_HEADS, HEAD_DIM)
        prev = jnp.pad(tb[:, :-1], ((0, 0), (1, 0), (0, 0), (0, 0), (0, 0)))
        return jnp.concatenate([prev, tb], axis=2)

    kb, vb = band(k), band(v)
    logits = jnp.einsum('bnqkgd,bnskd->bkgnqs', qb, kb).astype(jnp.float32) * (HEAD_DIM ** -0.5)
    t_idx = jnp.arange(BLOCK)[:, None]
    j_idx = jnp.arange(2 * BLOCK)[None, :]
    dist = t_idx + BLOCK - j_idx
    bias = rel_table.astype(jnp.float32)[t5_causal_bucket(dist)]
    bias = bias.transpose(2, 0, 1).reshape(N_KV_HEADS, G, 1, BLOCK, 2 * BLOCK)
    key_pos = (jnp.arange(nb)[:, None, None] - 1) * BLOCK + j_idx[None]
    valid = (dist >= 0)[None] & (dist < WINDOW)[None] & (key_pos >= 0)
    logits = jnp.where(valid, logits + bias, -1e30)
    s = sinks.astype(jnp.float32).reshape(N_KV_HEADS, G, 1, 1, 1)
    m = jnp.maximum(jnp.max(logits, axis=-1, keepdims=True), s)
    p = jnp.exp(logits - m)
    denom = jnp.sum(p, axis=-1, keepdims=True) + jnp.exp(s - m)
    probs = (p / denom).astype(v.dtype)
    out = jnp.einsum('bkgnqs,bnskd->bnqkgd', probs, vb)
    return out.reshape(B, S, ATT_WIDTH)


def gated_linear_attention(q, k, v, log_a):
    B, S = q.shape[0], q.shape[1]
    nc = S // GLA_CHUNK

    def chunks(t):
        return t.reshape(B, nc, GLA_CHUNK, GLA_HEADS, -1).transpose(0, 3, 1, 2, 4).astype(jnp.float32)

    qc = chunks(q) * (GLA_DK ** -0.5)
    kc, vc, la = chunks(k), chunks(v), chunks(log_a)
    b = jnp.cumsum(la, axis=3)
    b_last = b[:, :, :, -1:, :]
    q_dec = qc * jnp.exp(b)
    k_intra = kc * jnp.exp(-b)
    k_state = kc * jnp.exp(b_last - b)
    causal = jnp.tril(jnp.ones((GLA_CHUNK, GLA_CHUNK), dtype=bool))
    attn = jnp.where(causal, jnp.einsum('bhntd,bhnsd->bhnts', q_dec, k_intra), 0.0)
    o_intra = jnp.einsum('bhnts,bhnse->bhnte', attn, vc)
    d_state = jnp.einsum('bhnsd,bhnse->bhnde', k_state, vc)
    decay = jnp.exp(b_last[:, :, :, 0, :])

    def step(state, inp):
        d, ds = inp
        return d[..., None] * state + ds, state

    s0 = jnp.zeros((B, GLA_HEADS, GLA_DK, GLA_DV), jnp.float32)
    _, s_prev = lax.scan(step, s0, (jnp.moveaxis(decay, 2, 0), jnp.moveaxis(d_state, 2, 0)))
    s_prev = jnp.moveaxis(s_prev, 0, 2)
    o = o_intra + jnp.einsum('bhntd,bhnde->bhnte', q_dec, s_prev)
    return o.transpose(0, 2, 3, 1, 4).reshape(B, S, GLA_HEADS, GLA_DV)


def token_mixing(h, rel_table, w_in, w_alpha, b_alpha, attn_sinks, gla_norm_g, w_proj_a, w_proj_b, w_out):
    B, S = h.shape[0], h.shape[1]
    proj = h @ w_in
    cuts = list(np.cumsum(IN_SPLITS)[:-1])
    q_a, k_a, v_a, q_b, k_b, v_b, r_b, a_lr, g_a, g_b = jnp.split(proj, cuts, axis=-1)
    y_a = sliding_window_attention(q_a.reshape(B, S, N_Q_HEADS, HEAD_DIM),
                                   k_a.reshape(B, S, N_KV_HEADS, HEAD_DIM),
                                   v_a.reshape(B, S, N_KV_HEADS, HEAD_DIM),
                                   attn_sinks, rel_table)
    log_a = jax.nn.log_sigmoid((a_lr @ w_alpha + b_alpha).astype(jnp.float32)) / GLA_TAU
    o_b = gated_linear_attention(q_b.reshape(B, S, GLA_HEADS, GLA_DK),
                                 k_b.reshape(B, S, GLA_HEADS, GLA_DK),
                                 v_b.reshape(B, S, GLA_HEADS, GLA_DV),
                                 log_a.reshape(B, S, GLA_HEADS, GLA_DK))
    o_b = rmsnorm(o_b, gla_norm_g).astype(h.dtype) * jax.nn.silu(r_b.reshape(B, S, GLA_HEADS, GLA_DV))
    y_b = o_b.reshape(B, S, GLA_V_WIDTH)
    merged = jax.nn.sigmoid(g_a) * (y_a.astype(h.dtype) @ w_proj_a) + jax.nn.sigmoid(g_b) * (y_b @ w_proj_b)
    return merged @ w_out


def setup_inputs(seed: int = 0) -> dict:
    key = jax.random.key(seed)
    ks = iter(jax.random.split(key, 32))
    f32 = jnp.float32

    def w(shape, fan_in):
        return jax.random.normal(next(ks), shape, f32) * (fan_in ** -0.5)

    def gain(shape):
        return 1.0 + 0.02 * jax.random.normal(next(ks), shape, f32)

    L = DEPTH
    return {
        "x": jax.random.normal(next(ks), (BATCH, SEQ, D_MODEL), f32),
        "rel_bias": 0.1 * jax.random.normal(next(ks), (REL_BUCKETS, N_Q_HEADS), f32),
        "ffn1_pre_g": gain((L, D_MODEL)),
        "ffn1_w_gate": w((L, D_MODEL, D_FF), D_MODEL),
        "ffn1_w_up": w((L, D_MODEL, D_FF), D_MODEL),
        "ffn1_w_down": w((L, D_FF, D_MODEL), D_FF),
        "ffn1_post_g": gain((L, D_MODEL)),
        "mix_pre_g": gain((L, D_MODEL)),
        "w_in": w((L, D_MODEL, IN_WIDTH), D_MODEL),
        "w_alpha": w((L, GLA_GATE_RANK, GLA_K_WIDTH), GLA_GATE_RANK),
        "b_alpha": 0.1 * jax.random.normal(next(ks), (L, GLA_K_WIDTH), f32),
        "attn_sinks": 0.5 * jax.random.normal(next(ks), (L, N_Q_HEADS), f32),
        "gla_norm_g": gain((L, GLA_DV)),
        "w_proj_a": w((L, ATT_WIDTH, D_MODEL), ATT_WIDTH),
        "w_proj_b": w((L, GLA_V_WIDTH, D_MODEL), GLA_V_WIDTH),
        "w_out": w((L, D_MODEL, D_MODEL), D_MODEL),
        "mix_post_g": gain((L, D_MODEL)),
        "ffn2_pre_g": gain((L, D_MODEL)),
        "ffn2_w_gate": w((L, D_MODEL, D_FF), D_MODEL),
        "ffn2_w_up": w((L, D_MODEL, D_FF), D_MODEL),
        "ffn2_w_down": w((L, D_FF, D_MODEL), D_FF),
        "ffn2_post_g": gain((L, D_MODEL)),
    }


def reference(x, rel_bias, ffn1_pre_g, ffn1_w_gate, ffn1_w_up, ffn1_w_down, ffn1_post_g,
              mix_pre_g, w_in, w_alpha, b_alpha, attn_sinks, gla_norm_g, w_proj_a, w_proj_b,
              w_out, mix_post_g, ffn2_pre_g, ffn2_w_gate, ffn2_w_up, ffn2_w_down, ffn2_post_g):
    for l in range(DEPTH):
        f = swiglu(rmsnorm(x, ffn1_pre_g[l]), ffn1_w_gate[l], ffn1_w_up[l], ffn1_w_down[l])
        x = x + 0.5 * rmsnorm(f, ffn1_post_g[l])
        m = token_mixing(rmsnorm(x, mix_pre_g[l]), rel_bias, w_in[l], w_alpha[l], b_alpha[l],
                         attn_sinks[l], gla_norm_g[l], w_proj_a[l], w_proj_b[l], w_out[l])
        x = x + rmsnorm(m, mix_post_g[l])
        f = swiglu(rmsnorm(x, ffn2_pre_g[l]), ffn2_w_gate[l], ffn2_w_up[l], ffn2_w_down[l])
        x = x + 0.5 * rmsnorm(f, ffn2_post_g[l])
    return x
```

```cpp
#include <hip/hip_runtime.h>
#include <cstdio>
#include <cstdint>
namespace pg8 {
#define PG8_LAS __attribute__((address_space(3)))
typedef unsigned short bf16_t;
typedef short bf16x8 __attribute__((ext_vector_type(8)));
typedef float f32x4 __attribute__((ext_vector_type(4)));
typedef unsigned u32x4 __attribute__((ext_vector_type(4)));
constexpr int BM = 256, BK = 64, HALF = 128, HTB = HALF * BK * 2  , STAGE_BYTES = 8 * HTB, NXCD = 8, WGM = 8;

__host__ __device__ __forceinline__ int lds_byte(int r, int c) { const int st = (r >> 4) * 2 + (c >> 5), rr = r & 15, cc = c & 31, ob = rr * 64 + cc * 2; return st * 1024 + (ob ^ (((ob >> 9) & 1) << 5)); }
__host__ __device__ __forceinline__ void stage_rc(int b, int& R, int& C) { const int st = b / 1024, sb = b % 1024, swz = sb ^ (((sb >> 9) & 1) << 5); R = (st >> 1) * 16 + swz / 64; C = (st & 1) * 32 + (swz % 64) / 2; }
__host__ __device__ __forceinline__ int perm32(int rho) { const int n = rho >> 4, i = rho & 15; return 8 * (i >> 2) + 4 * n + (i & 3); }

struct Unit { int pm, pn; };
struct Gemm { const bf16_t* A; const bf16_t* Bt; int M, N, K, lda, ldb; };

struct StaticOrder {
    int nM, nN, nwg, G, c;
    __host__ __device__ void init(int M, int N, int G_, int c_) { nM = M / BM; nN = N / BM; nwg = nM * nN; G = G_; c = c_; }
    __host__ __device__ bool next(int i, Unit& u) const {
        const long L = (long)i * G + c; if (L >= nwg) return false;
        int wgid = (int)L; { const int q = nwg / NXCD, r = nwg % NXCD, xcd = wgid % NXCD, off = wgid / NXCD; wgid = (xcd < r ? xcd * (q + 1) : r * (q + 1) + (xcd - r) * q) + off; }
        const int nig = WGM * nN, gid = wgid / nig, fm = gid * WGM, gsz = (nM - fm) < WGM ? (nM - fm) : WGM;
        u.pm = fm + ((wgid % nig) % gsz); u.pn = (wgid % nig) / gsz; return true;
    }
    __device__ __forceinline__ void a_ready(const Unit&) const {}
    __device__ __forceinline__ void done(const Unit&) const {}
};

__device__ __forceinline__ unsigned cvt_pk_bf16(float lo, float hi) { unsigned r; asm volatile("v_cvt_pk_bf16_f32 %0, %1, %2" : "=v"(r) : "v"(lo), "v"(hi)); return r; }
typedef float f32x2 __attribute__((ext_vector_type(2)));

__device__ __forceinline__ float bf_lo(unsigned w) { return __uint_as_float(w << 16); }
__device__ __forceinline__ float bf_hi(unsigned w) { return __uint_as_float(w & 0xffff0000u); }
__device__ __forceinline__ float sigmoid_f(float v) { return __builtin_amdgcn_rcpf(1.0f + __builtin_amdgcn_exp2f(v * -1.4426950408889634f)); }
__device__ __forceinline__ u32x4 pack8(const f32x4 v0, const f32x4 v1) { u32x4 w; w.x = cvt_pk_bf16(v0[0], v0[1]); w.y = cvt_pk_bf16(v0[2], v0[3]); w.z = cvt_pk_bf16(v1[0], v1[1]); w.w = cvt_pk_bf16(v1[2], v1[3]); return w; }

struct EpiStore {
    static constexpr bool PERM = true, AFTER_DRAIN = false;
    bf16_t* O; int ldc;
    __device__ __forceinline__ void operator()(const f32x4 (&acc)[2][2][4][2], const Unit& u, int wr, int wc, int fr, int fq) const {
        const int row0 = u.pm * BM + wr * 64 + fr; const int col0 = u.pn * BM + wc * 32 + 8 * fq;
#pragma unroll
        for (int ai = 0; ai < 2; ++ai)
#pragma unroll
            for (int m = 0; m < 4; ++m) { bf16_t* rowp = O + (size_t)(row0 + ai * HALF + m * 16) * ldc + col0;
#pragma unroll
                for (int bj = 0; bj < 2; ++bj) *(u32x4*)(rowp + bj * HALF) = pack8(acc[ai][bj][m][0], acc[ai][bj][m][1]); }
    }
};
struct EpiSwiglu {
    static constexpr bool PERM = true, AFTER_DRAIN = false;
    bf16_t* O; int ldc;
    __device__ __forceinline__ void operator()(const f32x4 (&acc)[2][2][4][2], const Unit& u, int wr, int wc, int fr, int fq) const {
        const int row0 = u.pm * BM + wr * 64 + fr; const int col0 = u.pn * HALF + wc * 32 + 8 * fq;
#pragma unroll
        for (int ai = 0; ai < 2; ++ai)
#pragma unroll
            for (int m = 0; m < 4; ++m) { bf16_t* rowp = O + (size_t)(row0 + ai * HALF + m * 16) * ldc + col0;
                f32x4 h[2];
#pragma unroll
                for (int n = 0; n < 2; ++n)
#pragma unroll
                    for (int i = 0; i < 4; ++i) { const float g = acc[ai][0][m][n][i], up = acc[ai][1][m][n][i]; h[n][i] = g * sigmoid_f(g) * up; }
                *(u32x4*)rowp = pack8(h[0], h[1]); }
    }
};
struct EpiIn {
    static constexpr bool PERM = true, AFTER_DRAIN = false;
    bf16_t *QA, *KV, *QB, *KB, *VB, *RB, *GA, *GB; float* ALR; float qa_scale, qb_scale;
    __device__ __forceinline__ void operator()(const f32x4 (&acc)[2][2][4][2], const Unit& u, int wr, int wc, int fr, int fq) const {
        const int pn = u.pn; const int row0 = u.pm * BM + wr * 64 + fr;
        if (pn == 17) {
            if (wc == 0 && fq < 2) {
#pragma unroll
                for (int ai = 0; ai < 2; ++ai)
#pragma unroll
                    for (int m = 0; m < 4; ++m) { float* p = ALR + (size_t)(row0 + ai * HALF + m * 16) * 16 + 8 * fq;
                        *(f32x4*)p = acc[ai][0][m][0]; *(f32x4*)(p + 4) = acc[ai][0][m][1]; }
            }
            return;
        }
        bf16_t* base; int ld, colt; float sc = 1.f; int act = 0;
        if (pn < 2) { base = QA; ld = 512; colt = pn * 256; sc = qa_scale; }
        else if (pn == 2) { base = KV; ld = 256; colt = 0; }
        else if (pn == 3) { base = QB; ld = 256; colt = 0; sc = qb_scale; }
        else if (pn == 4) { base = KB; ld = 256; colt = 0; }
        else if (pn < 7) { base = VB; ld = 512; colt = (pn - 5) * 256; }
        else if (pn < 9) { base = RB; ld = 512; colt = (pn - 7) * 256; act = 2; }
        else if (pn < 13) { base = GA; ld = 1024; colt = (pn - 9) * 256; act = 1; }
        else { base = GB; ld = 1024; colt = (pn - 13) * 256; act = 1; }
        const int col0 = colt + wc * 32 + 8 * fq;
#pragma unroll
        for (int ai = 0; ai < 2; ++ai)
#pragma unroll
            for (int m = 0; m < 4; ++m) { bf16_t* rowp = base + (size_t)(row0 + ai * HALF + m * 16) * ld + col0;
#pragma unroll
                for (int bj = 0; bj < 2; ++bj) { f32x4 v0 = acc[ai][bj][m][0] * sc, v1 = acc[ai][bj][m][1] * sc;
                    if (act != 0) {
#pragma unroll
                        for (int i = 0; i < 4; ++i) { const float s0 = sigmoid_f(v0[i]), s1 = sigmoid_f(v1[i]); v0[i] = (act == 1) ? s0 : v0[i] * s0; v1[i] = (act == 1) ? s1 : v1[i] * s1; }
                    }
                    *(u32x4*)(rowp + bj * HALF) = pack8(v0, v1); } }
    }
};
template <bool SECOND> struct EpiGate {
    static constexpr bool PERM = true, AFTER_DRAIN = false;
    const bf16_t* Gt; bf16_t* O;
    __device__ __forceinline__ void operator()(const f32x4 (&acc)[2][2][4][2], const Unit& u, int wr, int wc, int fr, int fq) const {
        const int row0 = u.pm * BM + wr * 64 + fr; const int col0 = u.pn * BM + wc * 32 + 8 * fq;
#pragma unroll
        for (int ai = 0; ai < 2; ++ai)
#pragma unroll
            for (int m = 0; m < 4; ++m) { const size_t off = (size_t)(row0 + ai * HALF + m * 16) * 1024 + col0;
#pragma unroll
                for (int bj = 0; bj < 2; ++bj) { const u32x4 gw = *(const u32x4*)(Gt + off + bj * HALF);
                    f32x4 v0 = acc[ai][bj][m][0], v1 = acc[ai][bj][m][1];
                    v0[0] *= bf_lo(gw.x); v0[1] *= bf_hi(gw.x); v0[2] *= bf_lo(gw.y); v0[3] *= bf_hi(gw.y);
                    v1[0] *= bf_lo(gw.z); v1[1] *= bf_hi(gw.z); v1[2] *= bf_lo(gw.w); v1[3] *= bf_hi(gw.w);
                    if (SECOND) { const u32x4 pw = *(const u32x4*)(O + off + bj * HALF);
                        v0[0] += bf_lo(pw.x); v0[1] += bf_hi(pw.x); v0[2] += bf_lo(pw.y); v0[3] += bf_hi(pw.y);
                        v1[0] += bf_lo(pw.z); v1[1] += bf_hi(pw.z); v1[2] += bf_lo(pw.w); v1[3] += bf_hi(pw.w); }
                    *(u32x4*)(O + off + bj * HALF) = pack8(v0, v1); } }
    }
};
template <class Epi, class Sched, bool ALIGN_EPI = false, bool SP2 = false>
__device__ __forceinline__ void gemm_phase(PG8_LAS unsigned char* lds, const Gemm g, const Sched& S, const Epi& E) {
    const int tid = threadIdx.x, wid = __builtin_amdgcn_readfirstlane(tid >> 6), lane = tid & 63, wr = wid >> 2, wc = wid & 3, fr = lane & 15, fq = lane >> 4;
    const int K = g.K, nt = K / BK;
    unsigned voffA[2], voffB[2];
#pragma unroll
    for (int i = 0; i < 2; ++i) { int R, C; stage_rc(tid * 16 + i * 8192, R, C); const int Rb = Epi::PERM ? ((R & ~31) + perm32(R & 31)) : R;
        voffA[i] = (unsigned)(R * g.lda + C) * 2u; voffB[i] = (unsigned)(Rb * g.ldb + C) * 2u; }
    const size_t kstep = (size_t)(BK * 2);
    const size_t hsA = (size_t)HALF * g.lda * 2, hsB = (size_t)HALF * g.ldb * 2;
    const size_t tsA = 2 * hsA, tsB = 2 * hsB;
    const unsigned ldsw = (unsigned)wid * 1024u;
    const int aoff = lds_byte(wr * 64 + fr, fq * 8), boff = lds_byte(wc * 32 + fr, fq * 8);
#define PG8_SA(b, h) (((b) * 2 + (h)) * HTB)
#define PG8_SB(b, h) ((4 + (b) * 2 + (h)) * HTB)
#define PG8_STAGE(bufoff, gbase, voff) do { _Pragma("unroll") for (int _i = 0; _i < 2; ++_i) \
        __builtin_amdgcn_global_load_lds((const unsigned*)((const char*)(gbase) + (voff)[_i]), (PG8_LAS unsigned*)(lds + (bufoff) + ldsw + _i * 8192), 16, 0, 0); } while (0)
#define PG8_LDA(dst, b, h) do { _Pragma("unroll") for (int m = 0; m < 4; ++m) _Pragma("unroll") for (int k = 0; k < 2; ++k) dst[m][k] = *(const PG8_LAS bf16x8*)(lds + PG8_SA(b, h) + aoff + m * 2048 + k * 1024); } while (0)
#define PG8_LDB(dst, b, h) do { _Pragma("unroll") for (int n = 0; n < 2; ++n) _Pragma("unroll") for (int k = 0; k < 2; ++k) dst[n][k] = *(const PG8_LAS bf16x8*)(lds + PG8_SB(b, h) + boff + n * 2048 + k * 1024); } while (0)
#define PG8_MMA(ai, bj, At, Bt) do { __builtin_amdgcn_s_setprio(1); _Pragma("unroll") for (int m = 0; m < 4; ++m) _Pragma("unroll") for (int n = 0; n < 2; ++n) _Pragma("unroll") for (int k = 0; k < 2; ++k) \
        acc[ai][bj][m][n] = __builtin_amdgcn_mfma_f32_16x16x32_bf16(Bt[n][k], At[m][k], acc[ai][bj][m][n], 0, 0, 0); __builtin_amdgcn_s_setprio(0); } while (0)
#define PG8_WAIT_V(n) asm volatile("s_waitcnt vmcnt(" #n ")" ::: "memory")
#define PG8_WAIT_L(n) asm volatile("s_waitcnt lgkmcnt(" #n ")" ::: "memory")
#define PG8_BAR __builtin_amdgcn_s_barrier()
#define PG8_SCHED __builtin_amdgcn_sched_barrier(0)
    Unit cur, nxt; int ui = 0;
    if (!S.next(0, cur)) return;
    f32x4 acc[2][2][4][2];
#pragma unroll
    for (int a = 0; a < 2; ++a)
#pragma unroll
        for (int b = 0; b < 2; ++b)
#pragma unroll
            for (int m = 0; m < 4; ++m)
#pragma unroll
                for (int n = 0; n < 2; ++n) acc[a][b][m][n] = (f32x4){0.f, 0.f, 0.f, 0.f};
    bf16x8 At[4][2], B0[2][2], B1[2][2];
    const char* cA = (const char*)g.A + (size_t)cur.pm * tsA; const char* cB = (const char*)g.Bt + (size_t)cur.pn * tsB;
    S.a_ready(cur);
    if constexpr (SP2) {
        PG8_STAGE(PG8_SB(0, 0), cB, voffB); PG8_STAGE(PG8_SB(0, 1), cB + hsB, voffB); PG8_STAGE(PG8_SA(0, 0), cA, voffA); PG8_STAGE(PG8_SA(0, 1), cA + hsA, voffA);
        if (wr == 1) PG8_BAR;
        PG8_WAIT_V(2); PG8_BAR;
        PG8_STAGE(PG8_SB(1, 0), cB + kstep, voffB); PG8_STAGE(PG8_SA(1, 0), cA + kstep, voffA); PG8_STAGE(PG8_SB(1, 1), cB + hsB + kstep, voffB);
        PG8_WAIT_V(6); PG8_BAR;
    } else {
        PG8_STAGE(PG8_SB(0, 0), cB, voffB); PG8_STAGE(PG8_SA(0, 0), cA, voffA); PG8_STAGE(PG8_SB(0, 1), cB + hsB, voffB); PG8_STAGE(PG8_SA(0, 1), cA + hsA, voffA);
        if (wr == 1) PG8_BAR;
        PG8_WAIT_V(4); PG8_BAR;
        PG8_STAGE(PG8_SB(1, 0), cB + kstep, voffB); PG8_STAGE(PG8_SA(1, 0), cA + kstep, voffA); PG8_STAGE(PG8_SB(1, 1), cB + hsB + kstep, voffB);
        PG8_WAIT_V(6); PG8_BAR;
    }
    for (;;) {
        const bool has_next = S.next(ui + 1, nxt);
        const char* nA = has_next ? (const char*)g.A + (size_t)nxt.pm * tsA : cA; const char* nB = has_next ? (const char*)g.Bt + (size_t)nxt.pn * tsB : cB;
        for (int t = 0; t < nt; t += 2) {
            const bool last = (t == nt - 2);
            const char* a1 = cA + (size_t)(t + 1) * kstep;
            const char* a2 = last ? nA : cA + (size_t)(t + 2) * kstep; const char* b2 = last ? nB : cB + (size_t)(t + 2) * kstep;
            const char* a3 = a2 + kstep; const char* b3 = b2 + kstep;
            if (last && has_next) S.a_ready(nxt);
            if constexpr (SP2) {
            PG8_LDB(B0, 0, 0); PG8_LDB(B1, 0, 1); PG8_SCHED; PG8_LDA(At, 0, 0); PG8_STAGE(PG8_SA(1, 1), a1 + hsA, voffA);
            PG8_WAIT_V(8); PG8_WAIT_L(0); PG8_BAR; PG8_MMA(0, 0, At, B0); PG8_MMA(0, 1, At, B1); PG8_BAR; PG8_SCHED;
            PG8_LDA(At, 0, 1); PG8_STAGE(PG8_SB(0, 0), b2, voffB); PG8_STAGE(PG8_SB(0, 1), b2 + hsB, voffB); PG8_STAGE(PG8_SA(0, 0), a2, voffA);
            PG8_WAIT_V(8); PG8_WAIT_L(0); PG8_BAR; PG8_MMA(1, 0, At, B0); PG8_MMA(1, 1, At, B1); PG8_BAR; PG8_SCHED;
            PG8_LDB(B0, 1, 0); PG8_LDB(B1, 1, 1); PG8_SCHED; PG8_LDA(At, 1, 0); PG8_STAGE(PG8_SA(0, 1), a2 + hsA, voffA);
            PG8_WAIT_V(8); PG8_WAIT_L(0); PG8_BAR; PG8_MMA(0, 0, At, B0); PG8_MMA(0, 1, At, B1); PG8_BAR; PG8_SCHED;
            PG8_LDA(At, 1, 1); PG8_STAGE(PG8_SB(1, 0), b3, voffB); PG8_STAGE(PG8_SB(1, 1), b3 + hsB, voffB); PG8_STAGE(PG8_SA(1, 0), a3, voffA);
            PG8_WAIT_V(8); PG8_WAIT_L(0); PG8_BAR; PG8_MMA(1, 0, At, B0); PG8_MMA(1, 1, At, B1); PG8_BAR; PG8_SCHED;
            } else {
            PG8_LDB(B0, 0, 0); PG8_SCHED; PG8_LDA(At, 0, 0); PG8_STAGE(PG8_SA(1, 1), a1 + hsA, voffA);
            PG8_WAIT_L(8); PG8_BAR; PG8_WAIT_L(0); PG8_MMA(0, 0, At, B0); PG8_BAR; PG8_SCHED;
            PG8_LDB(B1, 0, 1); PG8_STAGE(PG8_SB(0, 0), b2, voffB);
            PG8_BAR; PG8_WAIT_L(0); PG8_MMA(0, 1, At, B1); PG8_BAR;
            PG8_LDA(At, 0, 1); PG8_STAGE(PG8_SA(0, 0), a2, voffA);
            PG8_BAR; PG8_WAIT_L(0); PG8_MMA(1, 0, At, B0); PG8_BAR; PG8_SCHED;
            PG8_STAGE(PG8_SB(0, 1), b2 + hsB, voffB);
            PG8_WAIT_V(6); PG8_BAR; PG8_MMA(1, 1, At, B1); PG8_BAR;
            PG8_LDB(B0, 1, 0); PG8_SCHED; PG8_LDA(At, 1, 0); PG8_STAGE(PG8_SA(0, 1), a2 + hsA, voffA);
            PG8_WAIT_L(8); PG8_BAR; PG8_WAIT_L(0); PG8_MMA(0, 0, At, B0); PG8_BAR; PG8_SCHED;
            PG8_LDB(B1, 1, 1); PG8_STAGE(PG8_SB(1, 0), b3, voffB);
            PG8_BAR; PG8_WAIT_L(0); PG8_MMA(0, 1, At, B1); PG8_BAR;
            PG8_LDA(At, 1, 1); PG8_STAGE(PG8_SA(1, 0), a3, voffA);
            PG8_BAR; PG8_WAIT_L(0); PG8_MMA(1, 0, At, B0); PG8_BAR; PG8_SCHED;
            PG8_STAGE(PG8_SB(1, 1), b3 + hsB, voffB);
            PG8_WAIT_V(6); PG8_BAR; PG8_MMA(1, 1, At, B1); PG8_BAR;
            }
        }
        if constexpr (ALIGN_EPI) { if (wr == 0) PG8_BAR; }
        if constexpr (!Epi::AFTER_DRAIN) { E(acc, cur, wr, wc, fr, fq); S.done(cur); }
        if (!has_next) break;
#pragma unroll
        for (int a = 0; a < 2; ++a)
#pragma unroll
            for (int b = 0; b < 2; ++b)
#pragma unroll
                for (int m = 0; m < 4; ++m)
#pragma unroll
                    for (int n = 0; n < 2; ++n) acc[a][b][m][n] = (f32x4){0.f, 0.f, 0.f, 0.f};
        cur = nxt; cA = nA; cB = nB; ++ui;
        if constexpr (ALIGN_EPI) { if (wr == 1) PG8_BAR; }
    }
    PG8_WAIT_V(0);
    if constexpr (!ALIGN_EPI) { if (wr == 0) PG8_BAR; }
    PG8_BAR;
    if constexpr (Epi::AFTER_DRAIN) { E.fused(acc, cur, wr, wc, fr, fq, lds, wid, lane); S.done(cur); }
#undef PG8_SA
#undef PG8_SB
#undef PG8_STAGE
#undef PG8_LDA
#undef PG8_LDB
#undef PG8_MMA
#undef PG8_WAIT_V
#undef PG8_WAIT_L
#undef PG8_BAR
#undef PG8_SCHED
}
}

constexpr int NWAVES = 8;
#ifndef MK_N_LAUNCHES
#define MK_N_LAUNCHES 1
#endif
constexpr int N_PHASES = 14;
constexpr int N_LAUNCHES = MK_N_LAUNCHES;
static_assert(N_LAUNCHES == 1 || N_LAUNCHES == N_PHASES, "MK_N_LAUNCHES is 1 or N_PHASES");

constexpr int BATCH = 16, SEQ = 2048, D = 1024, FF = 2816;
constexpr int M = BATCH * SEQ;
constexpr int NQH = 8, NKVH = 2, HD = 64, WINDOW = 128;
constexpr int GH = 4, GDK = 64, GDV = 128, GRANK = 16;
constexpr int IN_W = 4368, NIN = 4608;
constexpr float EPS = 1e-6f;
constexpr float LOG2E = 1.4426950408889634f;

constexpr size_t MiB = 1u << 20;
constexpr size_t WS_CTL = 0, CTL_ZERO_BYTES = 1 * MiB;
constexpr size_t WS_W1GU = 2 * MiB, WS_W1D = 13 * MiB, WS_W2GU = 19 * MiB, WS_W2D = 30 * MiB, WS_WIN = 36 * MiB, WS_WPAB = 45 * MiB, WS_WOUT = 47 * MiB;
constexpr size_t WS_HN = 64 * MiB;
constexpr size_t WS_F = 128 * MiB;
constexpr size_t WS_BIG = 192 * MiB;
constexpr size_t WS_QA = WS_BIG, WS_KV = WS_QA + 32 * MiB, WS_QB = WS_KV + 16 * MiB, WS_KB = WS_QB + 16 * MiB, WS_VB = WS_KB + 16 * MiB, WS_RB = WS_VB + 32 * MiB,
                 WS_GA = WS_RB + 32 * MiB, WS_GB = WS_GA + 64 * MiB, WS_ALR = WS_GB + 64 * MiB, WS_END = WS_ALR + 2 * MiB;
constexpr size_t WS_MO = WS_BIG;
static_assert(WS_W1GU + (size_t)2 * FF * D * 2 <= WS_W1D && WS_W1D + (size_t)D * FF * 2 <= WS_W2GU && WS_W2GU + (size_t)2 * FF * D * 2 <= WS_W2D && WS_W2D + (size_t)D * FF * 2 <= WS_WIN &&
              WS_WIN + (size_t)NIN * D * 2 <= WS_WPAB && WS_WPAB + (size_t)D * D * 2 <= WS_WOUT && WS_WOUT + (size_t)D * D * 2 <= WS_HN, "weight map");
static_assert(WS_BIG + (size_t)M * FF * 2 <= 512 * MiB && WS_END <= 512 * MiB, "d_ws map");
constexpr int CW_TMO = 0, CW_CODE = 1;
constexpr int CW_BAR = 4096;

constexpr int RING_OFF = 0, RING_BYTES = 131072;
constexpr int LDSCTL_OFF = RING_BYTES, MISC_OFF = LDSCTL_OFF + 320;
constexpr int LDS_BYTES = 147456;
static_assert(MISC_OFF + 128 <= LDS_BYTES, "LDS map");
#define GAS __attribute__((address_space(1)))
#define LAS __attribute__((address_space(3)))
typedef unsigned short bf16;
typedef unsigned v4u __attribute__((ext_vector_type(4)));
typedef float f32x4 __attribute__((ext_vector_type(4)));
typedef short bf16x8 __attribute__((ext_vector_type(8)));
typedef GAS unsigned gu32;
typedef GAS unsigned long long gu64;
#define RLX_AGENT __ATOMIC_RELAXED, __HIP_MEMORY_SCOPE_AGENT
#define LDS_WAIT() asm volatile("s_waitcnt lgkmcnt(0)" ::: "memory")
#define VM_WAIT() asm volatile("s_waitcnt vmcnt(0)" ::: "memory")
__device__ __forceinline__ unsigned long long rt() { return __builtin_amdgcn_s_memrealtime(); }
__device__ __forceinline__ unsigned f2bf(float f) { unsigned u = __builtin_bit_cast(unsigned, f); return (u + 0x7fffu + ((u >> 16) & 1u)) >> 16; }
__device__ __forceinline__ unsigned pk2(float lo, float hi) { return f2bf(lo) | (f2bf(hi) << 16); }
#define XB_TMO      128
#define XB_XCNT(j)  (256  + 64 * (j))
#define XB_XSUB(j)  (1280 + 64 * (j))
#define XB_XGEN(j)  (2304 + 64 * (j))
#define XB_TOP      3328
#define XB_TOPGEN   3392
#define XCD_BAR_WORDS 3456
#define XB_SPIN_CAP (1u << 18)

__device__ __forceinline__ unsigned xb_ld(unsigned* p)              { return __hip_atomic_load(p, __ATOMIC_RELAXED, __HIP_MEMORY_SCOPE_AGENT); }
__device__ __forceinline__ unsigned xb_add(unsigned* p, unsigned v) { return __hip_atomic_fetch_add(p, v, __ATOMIC_RELAXED, __HIP_MEMORY_SCOPE_AGENT); }
__device__ __forceinline__ unsigned xb_xcc_id() { return (unsigned)__builtin_amdgcn_s_getreg((3 << 11) | 20) & 0xFu; }
#define XB_SPIN(cond, bar) do { unsigned _sp = 0; while (cond) { __builtin_amdgcn_s_sleep(1); \
    if ((++_sp & 255u) == 0u) { if (xb_ld(&(bar)[XB_TMO])) break; if (_sp > XB_SPIN_CAP) { atomicAdd(&(bar)[XB_TMO], 1u); break; } } } } while (0)

struct XcdBarrier {
    unsigned* bar; unsigned x;
    volatile LAS unsigned* st;
};

__device__ __forceinline__ XcdBarrier xcd_barrier_post(unsigned* bar, volatile LAS unsigned* st) {
    XcdBarrier b; b.bar = bar; b.x = xb_xcc_id(); b.st = st;
    if (threadIdx.x == 0) (void)xb_add(&bar[XB_XCNT(b.x)], 1u);
    return b;
}
__device__ __forceinline__ void xcd_barrier_complete(unsigned* bar, unsigned x, unsigned& nloc, unsigned& nx) {
    const unsigned G = gridDim.x * gridDim.y * gridDim.z;
    unsigned sum, cnt, mine, sp = 0u;
    for (;;) {
        sum = 0u; cnt = 0u; mine = 0u;
#pragma unroll
        for (unsigned j = 0; j < 16; ++j) { const unsigned c = xb_ld(&bar[XB_XCNT(j)]); sum += c; cnt += (c > 0u) ? 1u : 0u; mine = (j == x) ? c : mine; }
        if (sum == G) break;
        __builtin_amdgcn_s_sleep(1);
        if ((++sp & 255u) == 0u) { if (xb_ld(&bar[XB_TMO])) break; if (sp > XB_SPIN_CAP) { atomicAdd(&bar[XB_TMO], 1u); break; } }
    }
    nloc = mine > 0u ? mine : 1u; nx = cnt > 0u ? cnt : 1u;
}

__device__ __forceinline__ void xcd_barrier(const XcdBarrier& b) {
    asm volatile("s_waitcnt vmcnt(0)" ::: "memory");
    __syncthreads();
    if (threadIdx.x == 0) {
        unsigned* bar = b.bar;
        __builtin_amdgcn_s_waitcnt(0);
        unsigned nloc = b.st[0], nx = b.st[1];
        if (nloc == 0u) { xcd_barrier_complete(bar, b.x, nloc, nx); b.st[0] = nloc; b.st[1] = nx; }
        const unsigned old = xb_add(&bar[XB_XSUB(b.x)], 1u);
        const unsigned gen = old / nloc;
        if (old + 1u == (gen + 1u) * nloc) {
            __builtin_amdgcn_fence(__ATOMIC_RELEASE, "agent");
            asm volatile("s_waitcnt vmcnt(0)" ::: "memory");
            const unsigned og = xb_add(&bar[XB_TOP], 1u);
            const unsigned tg = og / nx;
            if (og + 1u == (tg + 1u) * nx) xb_add(&bar[XB_TOPGEN], 1u);
            else XB_SPIN(xb_ld(&bar[XB_TOPGEN]) == tg, bar);
            __builtin_amdgcn_fence(__ATOMIC_ACQUIRE, "agent");
            xb_add(&bar[XB_XGEN(b.x)], 1u);
            asm volatile("s_waitcnt vmcnt(0)" ::: "memory");
        } else {
            XB_SPIN(xb_ld(&bar[XB_XGEN(b.x)]) == gen, bar);
            __builtin_amdgcn_fence(__ATOMIC_ACQUIRE, "agent");
            asm volatile("s_waitcnt vmcnt(0)" ::: "memory");
        }
    }
    __syncthreads();
}

struct Frame {
    LAS unsigned char* lds;
    volatile LAS unsigned* MISC;
    gu32* ctl;
    int tid, lane, wave;
    int vcu, G;
    const float* x; float* out;
    const float *rel_bias, *f1_pre_g, *f1_wg, *f1_wu, *f1_wd, *f1_post_g, *mix_pre_g, *w_in, *w_alpha, *b_alpha, *sinks, *gla_g, *w_pa, *w_pb, *w_out, *mix_post_g,
                *f2_pre_g, *f2_wg, *f2_wu, *f2_wd, *f2_post_g;
    bf16 *W1GU, *W1D, *W2GU, *W2D, *WIN, *WPAB, *WOUT;
    bf16 *HN, *FB, *HB, *QA, *KV, *QB, *KB, *VB, *RB, *GA, *GB, *MO;
    float *ALR, *OG;
};

__device__ __forceinline__ float wave_sum(float v) {
#pragma unroll
    for (int o = 1; o < 64; o <<= 1) v += __shfl_xor(v, o);
    return v;
}
__device__ __forceinline__ void p0_transpose_item(const float* W, int ldw, int k0, int n0, int nvalid, bf16* WT, int ldt, int drow0, int kd0, LAS float* scr, int lane) {
#pragma unroll 8
    for (int i = 0; i < 32; ++i) { const int kk = 2 * i + (lane >> 5); const int nn = lane & 31; scr[kk * 33 + nn] = (nn < nvalid) ? W[(size_t)(k0 + kk) * ldw + n0 + nn] : 0.f; }
    LDS_WAIT(); asm volatile("" ::: "memory");
    const int c = lane & 7;
#pragma unroll
    for (int j = 0; j < 4; ++j) { const int n = (lane >> 3) + 8 * j; const LAS float* s = scr + (8 * c) * 33 + n;
        v4u o; o.x = pk2(s[0 * 33], s[1 * 33]); o.y = pk2(s[2 * 33], s[3 * 33]); o.z = pk2(s[4 * 33], s[5 * 33]); o.w = pk2(s[6 * 33], s[7 * 33]);
        *(GAS v4u*)(WT + (size_t)(drow0 + n) * ldt + kd0 + 8 * c) = o; }
    LDS_WAIT(); asm volatile("" ::: "memory");
}
__device__ __forceinline__ void p0_item_gu(const float* Wg, const float* Wu, bf16* WT, int r, LAS float* scr, int lane) {
    constexpr int NB = FF / 32;
    const int which = r / (16 * NB); r -= which * 16 * NB; const int kb = r / NB, nb = r % NB, n0 = 32 * nb;
    const int drow = 256 * (n0 / 128) + (n0 % 128) + which * 128;
    p0_transpose_item(which ? Wu : Wg, FF, 64 * kb, n0, 32, WT, D, drow, 64 * kb, scr, lane);
}
__device__ __forceinline__ void p0_item_down(const float* Wd, bf16* WT, int r, LAS float* scr, int lane) {
    const int kb = r / 32, nb = r % 32;
    p0_transpose_item(Wd, D, 64 * kb, 32 * nb, 32, WT, FF, 32 * nb, 64 * kb, scr, lane);
}
__device__ __forceinline__ void p0_prologue(Frame& F) {
    LAS float* scr = (LAS float*)(F.lds + RING_OFF + F.wave * 16384);
    const int gw = F.vcu * NWAVES + F.wave, NGW = F.G * NWAVES;
    constexpr int I_GU = 2 * 16 * (FF / 32), I_DN = (FF / 64) * (D / 32), I_IN = 16 * 137, I_P = 8 * 32, I_O = 16 * 32;
    constexpr int NITEMS = 2 * I_GU + 2 * I_DN + I_IN + 2 * I_P + I_O;
    for (int it = gw; it < NITEMS; it += NGW) {
        int r = it;
        if (r < I_GU) { p0_item_gu(F.f1_wg, F.f1_wu, F.W1GU, r, scr, F.lane); continue; } r -= I_GU;
        if (r < I_GU) { p0_item_gu(F.f2_wg, F.f2_wu, F.W2GU, r, scr, F.lane); continue; } r -= I_GU;
        if (r < I_DN) { p0_item_down(F.f1_wd, F.W1D, r, scr, F.lane); continue; } r -= I_DN;
        if (r < I_DN) { p0_item_down(F.f2_wd, F.W2D, r, scr, F.lane); continue; } r -= I_DN;
        if (r < I_IN) {
            const int kb = r / 137, nb = r % 137;
            if (nb < 136) { const int drow = 32 * nb; const int scol = drow < 2304 ? drow : drow + 16; p0_transpose_item(F.w_in, IN_W, 64 * kb, scol, 32, F.WIN, D, drow, 64 * kb, scr, F.lane); }
            else p0_transpose_item(F.w_in, IN_W, 64 * kb, 2304, 16, F.WIN, D, 4352, 64 * kb, scr, F.lane);
            continue; } r -= I_IN;
        if (r < I_P) { const int kb = r / 32, nb = r % 32; p0_transpose_item(F.w_pa, D, 64 * kb, 32 * nb, 32, F.WPAB, D, 32 * nb, 64 * kb, scr, F.lane); continue; } r -= I_P;
        if (r < I_P) { const int kb = r / 32, nb = r % 32; p0_transpose_item(F.w_pb, D, 64 * kb, 32 * nb, 32, F.WPAB, D, 32 * nb, 512 + 64 * kb, scr, F.lane); continue; } r -= I_P;
        { const int kb = r / 32, nb = r % 32; p0_transpose_item(F.w_out, D, 64 * kb, 32 * nb, 32, F.WOUT, D, 32 * nb, 64 * kb, scr, F.lane); }
    }
    for (int rr = gw; rr < 224; rr += NGW) { GAS v4u* o = (GAS v4u*)(F.WIN + (size_t)(4384 + rr) * D) + F.lane; o[0] = (v4u){0u, 0u, 0u, 0u}; o[64] = (v4u){0u, 0u, 0u, 0u}; }
    {
        f32x4 g[4];
#pragma unroll
        for (int j = 0; j < 4; ++j) g[j] = ((const GAS f32x4*)F.f1_pre_g)[F.lane + 64 * j];
        for (int m = gw; m < M; m += NGW) {
            const GAS f32x4* xr = (const GAS f32x4*)(F.x + (size_t)m * D) + F.lane;
            f32x4 v[4]; float s = 0.f;
#pragma unroll
            for (int j = 0; j < 4; ++j) { v[j] = xr[64 * j]; s += (v[j].x * v[j].x + v[j].y * v[j].y) + (v[j].z * v[j].z + v[j].w * v[j].w); }
            const float rs = 1.f / sqrtf(wave_sum(s) * (1.f / D) + EPS);
            GAS unsigned long long* o8 = (GAS unsigned long long*)(F.HN + (size_t)m * D) + F.lane;
#pragma unroll
            for (int j = 0; j < 4; ++j) { const f32x4 y = v[j] * rs * g[j]; o8[64 * j] = (unsigned long long)pk2(y.x, y.y) | ((unsigned long long)pk2(y.z, y.w) << 32); }
        }
    }
}
template <bool HAS_HN> __device__ __forceinline__ void thin_norm(Frame& F, const bf16* fin, const float* xi, float* xo, float coef, const float* gpost, bf16* hn, const float* gpre) {
    const int gw = F.vcu * NWAVES + F.wave, NGW = F.G * NWAVES;
    f32x4 gp[4], gq[4];
#pragma unroll
    for (int j = 0; j < 4; ++j) { gp[j] = ((const GAS f32x4*)gpost)[F.lane + 64 * j] * coef; if (HAS_HN) gq[j] = ((const GAS f32x4*)gpre)[F.lane + 64 * j]; }
    for (int m = gw; m < M; m += NGW) {
        const GAS unsigned long long* fr = (const GAS unsigned long long*)(fin + (size_t)m * D) + F.lane;
        const GAS f32x4* xr = (const GAS f32x4*)(xi + (size_t)m * D) + F.lane;
        f32x4 f[4], xv[4]; float s = 0.f;
#pragma unroll
        for (int j = 0; j < 4; ++j) { const unsigned long long w = fr[64 * j]; const unsigned lo = (unsigned)w, hi = (unsigned)(w >> 32);
            f[j] = (f32x4){pg8::bf_lo(lo), pg8::bf_hi(lo), pg8::bf_lo(hi), pg8::bf_hi(hi)}; xv[j] = xr[64 * j];
            s += (f[j].x * f[j].x + f[j].y * f[j].y) + (f[j].z * f[j].z + f[j].w * f[j].w); }
        const float rs = 1.f / sqrtf(wave_sum(s) * (1.f / D) + EPS);
        float s2 = 0.f;
        GAS f32x4* xw = (GAS f32x4*)(xo + (size_t)m * D) + F.lane;
#pragma unroll
        for (int j = 0; j < 4; ++j) { xv[j] = xv[j] + f[j] * rs * gp[j]; xw[64 * j] = xv[j]; s2 += (xv[j].x * xv[j].x + xv[j].y * xv[j].y) + (xv[j].z * xv[j].z + xv[j].w * xv[j].w); }
        if (HAS_HN) {
            const float rs2 = 1.f / sqrtf(wave_sum(s2) * (1.f / D) + EPS);
            GAS unsigned long long* o8 = (GAS unsigned long long*)(hn + (size_t)m * D) + F.lane;
#pragma unroll
            for (int j = 0; j < 4; ++j) { const f32x4 y = xv[j] * rs2 * gq[j]; o8[64 * j] = (unsigned long long)pk2(y.x, y.y) | ((unsigned long long)pk2(y.z, y.w) << 32); }
        }
    }
}

__device__ __forceinline__ int t5_bucket(int d) {
    if (d < 16) return d;
    return 16 + (d >= 19) + (d >= 21) + (d >= 24) + (d >= 27) + (d >= 31) + (d >= 35) + (d >= 40) + (d >= 46) + (d >= 52) + (d >= 59) + (d >= 67) + (d >= 77) + (d >= 87) + (d >= 99) + (d >= 113);
}
__device__ __forceinline__ void mixer_naive(Frame& F) {
    LAS float* L = (LAS float*)(F.lds + RING_OFF);
    LAS float* qs = L;
    LAS float* ks = L + 4096;
    LAS float* adec = L + 8192;
    LAS float* vs = L + 12288;
    LAS float* os = L + 14336;
    LAS float* btab = L + 16384;
    for (int u = blockIdx.x; u < BATCH * GH * 4; u += F.G) {
        const int b = u / 16, h = (u / 4) % 4, e0 = (u % 4) * 32;
        float S[32];
#pragma unroll
        for (int i = 0; i < 32; ++i) S[i] = 0.f;
        for (int c = 0; c < SEQ / 64; ++c) {
            const int tok0 = b * SEQ + c * 64;
            {
                const int tt = F.tid >> 3, d0 = (F.tid & 7) * 8; const size_t tok = (size_t)tok0 + tt;
                const v4u qw = *(const GAS v4u*)(F.QB + tok * 256 + h * 64 + d0), kw = *(const GAS v4u*)(F.KB + tok * 256 + h * 64 + d0);
                LAS float* qd = qs + tt * 64 + d0; LAS float* kd = ks + tt * 64 + d0;
                qd[0] = pg8::bf_lo(qw.x); qd[1] = pg8::bf_hi(qw.x); qd[2] = pg8::bf_lo(qw.y); qd[3] = pg8::bf_hi(qw.y); qd[4] = pg8::bf_lo(qw.z); qd[5] = pg8::bf_hi(qw.z); qd[6] = pg8::bf_lo(qw.w); qd[7] = pg8::bf_hi(qw.w);
                kd[0] = pg8::bf_lo(kw.x); kd[1] = pg8::bf_hi(kw.x); kd[2] = pg8::bf_lo(kw.y); kd[3] = pg8::bf_hi(kw.y); kd[4] = pg8::bf_lo(kw.z); kd[5] = pg8::bf_hi(kw.z); kd[6] = pg8::bf_lo(kw.w); kd[7] = pg8::bf_hi(kw.w);
                float z[8];
#pragma unroll
                for (int i = 0; i < 8; ++i) z[i] = F.b_alpha[h * 64 + d0 + i];
#pragma unroll
                for (int r = 0; r < GRANK; ++r) { const float a = F.ALR[tok * 16 + r];
#pragma unroll
                    for (int i = 0; i < 8; ++i) z[i] += a * F.w_alpha[r * 256 + h * 64 + d0 + i]; }
#pragma unroll
                for (int i = 0; i < 8; ++i) { const float ls = fminf(z[i], 0.f) - log1pf(expf(-fabsf(z[i]))); adec[tt * 64 + d0 + i] = expf(ls * (1.f / 16.f)); }
                const int vt = F.tid >> 3, ve = (F.tid & 7) * 4;
                const unsigned long long vw = *(const GAS unsigned long long*)(F.VB + ((size_t)tok0 + vt) * 512 + h * 128 + e0 + ve);
                const unsigned vlo = (unsigned)vw, vhi = (unsigned)(vw >> 32);
                LAS float* vd = vs + vt * 32 + ve; vd[0] = pg8::bf_lo(vlo); vd[1] = pg8::bf_hi(vlo); vd[2] = pg8::bf_lo(vhi); vd[3] = pg8::bf_hi(vhi);
            }
            __syncthreads();
            if (F.wave == 0) {
                const int e = F.lane & 31, hf = F.lane >> 5;
                for (int t = 0; t < 64; ++t) {
                    const float v = vs[t * 32 + e]; float acc = 0.f;
                    const LAS float* ap = adec + t * 64 + hf * 32; const LAS float* kp = ks + t * 64 + hf * 32; const LAS float* qp = qs + t * 64 + hf * 32;
#pragma unroll
                    for (int dd = 0; dd < 32; ++dd) { S[dd] = ap[dd] * S[dd] + kp[dd] * v; acc += qp[dd] * S[dd]; }
                    acc += __shfl_xor(acc, 32);
                    if (hf == 0) os[t * 32 + e] = acc;
                }
            }
            __syncthreads();
            { const int vt = F.tid >> 3, ve = (F.tid & 7) * 4; const LAS float* od = os + vt * 32 + ve;
              *(GAS f32x4*)(F.OG + ((size_t)tok0 + vt) * 512 + h * 128 + e0 + ve) = (f32x4){od[0], od[1], od[2], od[3]}; }
        }
    }
    __syncthreads();
    for (int i = F.tid; i < NQH * 128; i += NWAVES * 64) { const int h = i >> 7, d = i & 127; btab[i] = F.rel_bias[t5_bucket(d) * NQH + h] * LOG2E; }
    __syncthreads();
    for (int item = blockIdx.x * (NWAVES * 64) + F.tid; item < M * NQH; item += F.G * NWAVES * 64) {
        const int h = item / M, tok = item % M, p = tok % SEQ, kvh = h / (NQH / NKVH);
        float q[64], o[64];
        { const GAS v4u* qp = (const GAS v4u*)(F.QA + (size_t)tok * 512 + h * 64);
#pragma unroll
          for (int j = 0; j < 8; ++j) { const v4u w = qp[j]; q[8 * j + 0] = pg8::bf_lo(w.x); q[8 * j + 1] = pg8::bf_hi(w.x); q[8 * j + 2] = pg8::bf_lo(w.y); q[8 * j + 3] = pg8::bf_hi(w.y);
              q[8 * j + 4] = pg8::bf_lo(w.z); q[8 * j + 5] = pg8::bf_hi(w.z); q[8 * j + 6] = pg8::bf_lo(w.w); q[8 * j + 7] = pg8::bf_hi(w.w); } }
#pragma unroll
        for (int j = 0; j < 64; ++j) o[j] = 0.f;
        float mrun = F.sinks[h] * LOG2E, l = 1.f;
        const int nd = p < WINDOW - 1 ? p : WINDOW - 1;
        for (int d = 0; d <= nd; ++d) {
            const GAS v4u* kp = (const GAS v4u*)(F.KV + (size_t)(tok - d) * 256 + kvh * 64);
            float s = 0.f;
#pragma unroll
            for (int j = 0; j < 8; ++j) { const v4u w = kp[j];
                s += q[8 * j + 0] * pg8::bf_lo(w.x) + q[8 * j + 1] * pg8::bf_hi(w.x) + q[8 * j + 2] * pg8::bf_lo(w.y) + q[8 * j + 3] * pg8::bf_hi(w.y)
                   + q[8 * j + 4] * pg8::bf_lo(w.z) + q[8 * j + 5] * pg8::bf_hi(w.z) + q[8 * j + 6] * pg8::bf_lo(w.w) + q[8 * j + 7] * pg8::bf_hi(w.w); }
            s += btab[h * 128 + d];
            const float mn = fmaxf(mrun, s), al = exp2f(mrun - mn), pe = exp2f(s - mn);
            l = l * al + pe; mrun = mn;
            const GAS v4u* vp = (const GAS v4u*)(F.KV + (size_t)(tok - d) * 256 + 128 + kvh * 64);
#pragma unroll
            for (int j = 0; j < 8; ++j) { const v4u w = vp[j];
                o[8 * j + 0] = o[8 * j + 0] * al + pe * pg8::bf_lo(w.x); o[8 * j + 1] = o[8 * j + 1] * al + pe * pg8::bf_hi(w.x);
                o[8 * j + 2] = o[8 * j + 2] * al + pe * pg8::bf_lo(w.y); o[8 * j + 3] = o[8 * j + 3] * al + pe * pg8::bf_hi(w.y);
                o[8 * j + 4] = o[8 * j + 4] * al + pe * pg8::bf_lo(w.z); o[8 * j + 5] = o[8 * j + 5] * al + pe * pg8::bf_hi(w.z);
                o[8 * j + 6] = o[8 * j + 6] * al + pe * pg8::bf_lo(w.w); o[8 * j + 7] = o[8 * j + 7] * al + pe * pg8::bf_hi(w.w); }
        }
        const float il = 1.f / l;
        GAS v4u* yp = (GAS v4u*)(F.HN + (size_t)tok * D + h * 64);
#pragma unroll
        for (int j = 0; j < 8; ++j) { v4u w; w.x = pk2(o[8 * j + 0] * il, o[8 * j + 1] * il); w.y = pk2(o[8 * j + 2] * il, o[8 * j + 3] * il); w.z = pk2(o[8 * j + 4] * il, o[8 * j + 5] * il); w.w = pk2(o[8 * j + 6] * il, o[8 * j + 7] * il); yp[j] = w; }
    }
}
__device__ __forceinline__ void gla_post(Frame& F) {
    const int gw = F.vcu * NWAVES + F.wave, NGW = F.G * NWAVES;
    const int e = (F.lane & 15) * 8;
    const f32x4 g0 = *(const GAS f32x4*)(F.gla_g + e), g1 = *(const GAS f32x4*)(F.gla_g + e + 4);
    for (int m = gw; m < M; m += NGW) {
        const GAS f32x4* op = (const GAS f32x4*)(F.OG + (size_t)m * 512 + F.lane * 8);
        const f32x4 a = op[0], b = op[1];
        float s = (a.x * a.x + a.y * a.y) + (a.z * a.z + a.w * a.w) + (b.x * b.x + b.y * b.y) + (b.z * b.z + b.w * b.w);
        s += __shfl_xor(s, 1); s += __shfl_xor(s, 2); s += __shfl_xor(s, 4); s += __shfl_xor(s, 8);
        const float rs = 1.f / sqrtf(s * (1.f / GDV) + EPS);
        const v4u rw = *(const GAS v4u*)(F.RB + (size_t)m * 512 + F.lane * 8);
        const f32x4 ya = a * rs * g0, yb = b * rs * g1;
        v4u w; w.x = pk2(ya.x * pg8::bf_lo(rw.x), ya.y * pg8::bf_hi(rw.x)); w.y = pk2(ya.z * pg8::bf_lo(rw.y), ya.w * pg8::bf_hi(rw.y));
        w.z = pk2(yb.x * pg8::bf_lo(rw.z), yb.y * pg8::bf_hi(rw.z)); w.w = pk2(yb.z * pg8::bf_lo(rw.w), yb.w * pg8::bf_hi(rw.w));
        *(GAS v4u*)(F.HN + (size_t)m * D + 512 + F.lane * 8) = w;
    }
}

struct Args { const float* in[22]; float* out; unsigned char* ws; int ph_lo, ph_hi; };
__global__ void __launch_bounds__(NWAVES * 64, 2) mk_fwd(Args args) {
    extern __shared__ __attribute__((aligned(16))) unsigned char lds[];
    Frame F;
    F.lds = (LAS unsigned char*)lds;
    F.MISC = (volatile LAS unsigned*)(F.lds + MISC_OFF);
    F.tid = threadIdx.x; F.lane = F.tid & 63; F.wave = __builtin_amdgcn_readfirstlane(F.tid >> 6);
    F.G = gridDim.x; { const int bx = blockIdx.x; F.vcu = (F.G % 8 == 0) ? (bx % 8) * (F.G / 8) + bx / 8 : bx; }
    unsigned char* ws = args.ws;
    F.ctl = (gu32*)(ws + WS_CTL);
    F.x = args.in[0]; F.rel_bias = args.in[1]; F.f1_pre_g = args.in[2]; F.f1_wg = args.in[3]; F.f1_wu = args.in[4]; F.f1_wd = args.in[5]; F.f1_post_g = args.in[6];
    F.mix_pre_g = args.in[7]; F.w_in = args.in[8]; F.w_alpha = args.in[9]; F.b_alpha = args.in[10]; F.sinks = args.in[11]; F.gla_g = args.in[12];
    F.w_pa = args.in[13]; F.w_pb = args.in[14]; F.w_out = args.in[15]; F.mix_post_g = args.in[16];
    F.f2_pre_g = args.in[17]; F.f2_wg = args.in[18]; F.f2_wu = args.in[19]; F.f2_wd = args.in[20]; F.f2_post_g = args.in[21];
    F.out = args.out;
    F.W1GU = (bf16*)(ws + WS_W1GU); F.W1D = (bf16*)(ws + WS_W1D); F.W2GU = (bf16*)(ws + WS_W2GU); F.W2D = (bf16*)(ws + WS_W2D);
    F.WIN = (bf16*)(ws + WS_WIN); F.WPAB = (bf16*)(ws + WS_WPAB); F.WOUT = (bf16*)(ws + WS_WOUT);
    F.HN = (bf16*)(ws + WS_HN); F.FB = (bf16*)(ws + WS_F); F.HB = (bf16*)(ws + WS_BIG);
    F.QA = (bf16*)(ws + WS_QA); F.KV = (bf16*)(ws + WS_KV); F.QB = (bf16*)(ws + WS_QB); F.KB = (bf16*)(ws + WS_KB); F.VB = (bf16*)(ws + WS_VB); F.RB = (bf16*)(ws + WS_RB);
    F.GA = (bf16*)(ws + WS_GA); F.GB = (bf16*)(ws + WS_GB); F.MO = (bf16*)(ws + WS_MO);
    F.ALR = (float*)(ws + WS_ALR); F.OG = (float*)(ws + WS_F);
    for (int u = F.tid; u < (LDS_BYTES - LDSCTL_OFF) / 4; u += NWAVES * 64) ((LAS unsigned*)(F.lds + LDSCTL_OFF))[u] = 0u;
    __syncthreads();
    XcdBarrier bar; bar.bar = (unsigned*)(F.ctl + CW_BAR); bar.x = 0; bar.st = nullptr;
    if (N_LAUNCHES == 1) bar = xcd_barrier_post((unsigned*)(F.ctl + CW_BAR), F.MISC + 8);
#define GRID_BAR() do { if (N_LAUNCHES == 1) xcd_barrier(bar); } while (0)
    const int lo = args.ph_lo, hi = args.ph_hi;
#define IN(k) (lo <= (k) && (k) < hi)
#define SEAM(k) do { if (IN(k) && IN((k) + 1)) GRID_BAR(); } while (0)
    typedef pg8::bf16_t bt;

    if (IN(0)) { p0_prologue(F); } SEAM(0);
    if (IN(1)) { pg8::Gemm g{(const bt*)F.HN, (const bt*)F.W1GU, M, 2 * FF, D, D, D}; pg8::StaticOrder S; S.init(M, 2 * FF, F.G, (int)blockIdx.x);
        pg8::EpiSwiglu E{(bt*)F.HB, FF}; pg8::gemm_phase<pg8::EpiSwiglu, pg8::StaticOrder, true, true>(F.lds + RING_OFF, g, S, E); } SEAM(1);
    if (IN(2)) { pg8::Gemm g{(const bt*)F.HB, (const bt*)F.W1D, M, D, FF, FF, FF}; pg8::StaticOrder S; S.init(M, D, F.G, (int)blockIdx.x);
        pg8::EpiStore E{(bt*)F.FB, D}; pg8::gemm_phase<pg8::EpiStore, pg8::StaticOrder, true, true>(F.lds + RING_OFF, g, S, E); } SEAM(2);
    if (IN(3)) { thin_norm<true>(F, F.FB, F.x, F.out, 0.5f, F.f1_post_g, F.HN, F.mix_pre_g); } SEAM(3);
    if (IN(4)) { pg8::Gemm g{(const bt*)F.HN, (const bt*)F.WIN, M, NIN, D, D, D}; pg8::StaticOrder S; S.init(M, NIN, F.G, (int)blockIdx.x);
        pg8::EpiIn E{(bt*)F.QA, (bt*)F.KV, (bt*)F.QB, (bt*)F.KB, (bt*)F.VB, (bt*)F.RB, (bt*)F.GA, (bt*)F.GB, F.ALR, 0.125f * LOG2E, 0.125f};
        pg8::gemm_phase<pg8::EpiIn, pg8::StaticOrder, true, true>(F.lds + RING_OFF, g, S, E); } SEAM(4);
    if (IN(5)) { mixer_naive(F); } SEAM(5);
    if (IN(6)) { gla_post(F); } SEAM(6);
    if (IN(7)) { pg8::Gemm g{(const bt*)F.HN, (const bt*)F.WPAB, M, D, 512, D, D}; pg8::StaticOrder S; S.init(M, D, F.G, (int)blockIdx.x);
        pg8::EpiGate<false> E{(const bt*)F.GA, (bt*)F.FB}; pg8::gemm_phase<pg8::EpiGate<false>, pg8::StaticOrder, true, true>(F.lds + RING_OFF, g, S, E); } SEAM(7);
    if (IN(8)) { pg8::Gemm g{(const bt*)F.HN + 512, (const bt*)F.WPAB + 512, M, D, 512, D, D}; pg8::StaticOrder S; S.init(M, D, F.G, (int)blockIdx.x);
        pg8::EpiGate<true> E{(const bt*)F.GB, (bt*)F.FB}; pg8::gemm_phase<pg8::EpiGate<true>, pg8::StaticOrder, true, true>(F.lds + RING_OFF, g, S, E); } SEAM(8);
    if (IN(9)) { pg8::Gemm g{(const bt*)F.FB, (const bt*)F.WOUT, M, D, D, D, D}; pg8::StaticOrder S; S.init(M, D, F.G, (int)blockIdx.x);
        pg8::EpiStore E{(bt*)F.MO, D}; pg8::gemm_phase<pg8::EpiStore, pg8::StaticOrder, true, true>(F.lds + RING_OFF, g, S, E); } SEAM(9);
    if (IN(10)) { thin_norm<true>(F, F.MO, F.out, F.out, 1.0f, F.mix_post_g, F.HN, F.f2_pre_g); } SEAM(10);
    if (IN(11)) { pg8::Gemm g{(const bt*)F.HN, (const bt*)F.W2GU, M, 2 * FF, D, D, D}; pg8::StaticOrder S; S.init(M, 2 * FF, F.G, (int)blockIdx.x);
        pg8::EpiSwiglu E{(bt*)F.HB, FF}; pg8::gemm_phase<pg8::EpiSwiglu, pg8::StaticOrder, true, true>(F.lds + RING_OFF, g, S, E); } SEAM(11);
    if (IN(12)) { pg8::Gemm g{(const bt*)F.HB, (const bt*)F.W2D, M, D, FF, FF, FF}; pg8::StaticOrder S; S.init(M, D, F.G, (int)blockIdx.x);
        pg8::EpiStore E{(bt*)F.FB, D}; pg8::gemm_phase<pg8::EpiStore, pg8::StaticOrder, true, true>(F.lds + RING_OFF, g, S, E); } SEAM(12);
    if (IN(13)) { thin_norm<false>(F, F.FB, F.out, F.out, 0.5f, F.f2_post_g, nullptr, nullptr); }
#undef IN
#undef SEAM
#undef GRID_BAR
}

extern "C" void kernel_launch(void* const* d_in, const int* in_sizes, int n_in, void* d_out, int out_size, void* d_ws, size_t ws_size, hipStream_t stream) {
    static int grid = 0;
    if (grid == 0) {
        if (n_in != 22 || in_sizes[0] != M * D || out_size != M * D || ws_size < WS_END || ws_size < WS_BIG + (size_t)M * FF * 2) {
            fprintf(stderr, "kernel_launch: shape/workspace mismatch: n_in %d in0 %d out %d ws %zu (need %zu)\n", n_in, n_in > 0 ? in_sizes[0] : -1, out_size, ws_size, (size_t)WS_END); grid = -1; return; }
        int dev = 0, cus = 0, per_cu = 0;
        if (hipGetDevice(&dev) != hipSuccess || hipDeviceGetAttribute(&cus, hipDeviceAttributeMultiprocessorCount, dev) != hipSuccess) { fprintf(stderr, "kernel_launch: device query failed\n"); grid = -1; return; }
        if (hipFuncSetAttribute((const void*)mk_fwd, hipFuncAttributeMaxDynamicSharedMemorySize, LDS_BYTES) != hipSuccess) { fprintf(stderr, "kernel_launch: hipFuncSetAttribute failed\n"); grid = -1; return; }
        if (hipOccupancyMaxActiveBlocksPerMultiprocessor(&per_cu, (const void*)mk_fwd, NWAVES * 64, LDS_BYTES) != hipSuccess || per_cu < 1)
            fprintf(stderr, "kernel_launch: note: occupancy query reports %d workgroups per CU\n", per_cu);
        (void)hipGetLastError();
        grid = cus;
    }
    if (grid < 0) return;
    if (hipMemsetAsync((char*)d_ws + WS_CTL, 0, CTL_ZERO_BYTES, stream) != hipSuccess) { fprintf(stderr, "kernel_launch: memset failed\n"); return; }
    Args a{};
    for (int i = 0; i < 22; ++i) a.in[i] = (const float*)d_in[i];
    a.out = (float*)d_out; a.ws = (unsigned char*)d_ws;
    for (int li = 0; li < N_LAUNCHES; ++li) {
        a.ph_lo = (N_LAUNCHES == 1) ? 0 : li; a.ph_hi = (N_LAUNCHES == 1) ? N_PHASES : li + 1;
        hipLaunchKernelGGL(mk_fwd, dim3(grid), dim3(NWAVES * 64), LDS_BYTES, stream, a);
        const hipError_t le = hipPeekAtLastError();
        if (le != hipSuccess) { fprintf(stderr, "kernel_launch: launch %d failed: %s\n", li, hipGetErrorName(le)); break; }
    }
}
```

```cpp
#include <hip/hip_runtime.h>
#include <cstdio>
#include <cstdint>
namespace pg8 {
#define PG8_LAS __attribute__((address_space(3)))
typedef unsigned short bf16_t;
typedef short bf16x8 __attribute__((ext_vector_type(8)));
typedef float f32x4 __attribute__((ext_vector_type(4)));
typedef unsigned u32x4 __attribute__((ext_vector_type(4)));
constexpr int BM = 256, BK = 64, HALF = 128, HTB = HALF * BK * 2  , STAGE_BYTES = 8 * HTB, NXCD = 8, WGM = 8;

__host__ __device__ __forceinline__ int lds_byte(int r, int c) { const int st = (r >> 4) * 2 + (c >> 5), rr = r & 15, cc = c & 31, ob = rr * 64 + cc * 2; return st * 1024 + (ob ^ (((ob >> 9) & 1) << 5)); }
__host__ __device__ __forceinline__ void stage_rc(int b, int& R, int& C) { const int st = b / 1024, sb = b % 1024, swz = sb ^ (((sb >> 9) & 1) << 5); R = (st >> 1) * 16 + swz / 64; C = (st & 1) * 32 + (swz % 64) / 2; }
__host__ __device__ __forceinline__ int perm32(int rho) { const int n = rho >> 4, i = rho & 15; return 8 * (i >> 2) + 4 * n + (i & 3); }

struct Unit { int pm, pn; };
struct Gemm { const bf16_t* A; const bf16_t* Bt; int M, N, K, lda, ldb; };

struct StaticOrder {
    int nM, nN, nwg, G, c;
    __host__ __device__ void init(int M, int N, int G_, int c_) { nM = M / BM; nN = N / BM; nwg = nM * nN; G = G_; c = c_; }
    __host__ __device__ bool next(int i, Unit& u) const {
        const long L = (long)i * G + c; if (L >= nwg) return false;
        int wgid = (int)L; { const int q = nwg / NXCD, r = nwg % NXCD, xcd = wgid % NXCD, off = wgid / NXCD; wgid = (xcd < r ? xcd * (q + 1) : r * (q + 1) + (xcd - r) * q) + off; }
        const int nig = WGM * nN, gid = wgid / nig, fm = gid * WGM, gsz = (nM - fm) < WGM ? (nM - fm) : WGM;
        u.pm = fm + ((wgid % nig) % gsz); u.pn = (wgid % nig) / gsz; return true;
    }
    __device__ __forceinline__ void a_ready(const Unit&) const {}
    __device__ __forceinline__ void done(const Unit&) const {}
};

__device__ __forceinline__ unsigned cvt_pk_bf16(float lo, float hi) { unsigned r; asm volatile("v_cvt_pk_bf16_f32 %0, %1, %2" : "=v"(r) : "v"(lo), "v"(hi)); return r; }
typedef float f32x2 __attribute__((ext_vector_type(2)));

__device__ __forceinline__ float bf_lo(unsigned w) { return __uint_as_float(w << 16); }
__device__ __forceinline__ float bf_hi(unsigned w) { return __uint_as_float(w & 0xffff0000u); }
__device__ __forceinline__ float sigmoid_f(float v) { return __builtin_amdgcn_rcpf(1.0f + __builtin_amdgcn_exp2f(v * -1.4426950408889634f)); }
__device__ __forceinline__ u32x4 pack8(const f32x4 v0, const f32x4 v1) { u32x4 w; w.x = cvt_pk_bf16(v0[0], v0[1]); w.y = cvt_pk_bf16(v0[2], v0[3]); w.z = cvt_pk_bf16(v1[0], v1[1]); w.w = cvt_pk_bf16(v1[2], v1[3]); return w; }

struct EpiStore {
    static constexpr bool PERM = true, AFTER_DRAIN = false;
    bf16_t* O; int ldc;
    __device__ __forceinline__ void operator()(const f32x4 (&acc)[2][2][4][2], const Unit& u, int wr, int wc, int fr, int fq) const {
        const int row0 = u.pm * BM + wr * 64 + fr; const int col0 = u.pn * BM + wc * 32 + 8 * fq;
#pragma unroll
        for (int ai = 0; ai < 2; ++ai)
#pragma unroll
            for (int m = 0; m < 4; ++m) { bf16_t* rowp = O + (size_t)(row0 + ai * HALF + m * 16) * ldc + col0;
#pragma unroll
                for (int bj = 0; bj < 2; ++bj) *(u32x4*)(rowp + bj * HALF) = pack8(acc[ai][bj][m][0], acc[ai][bj][m][1]); }
    }
};
struct EpiSwiglu {
    static constexpr bool PERM = true, AFTER_DRAIN = false;
    bf16_t* O; int ldc;
    __device__ __forceinline__ void operator()(const f32x4 (&acc)[2][2][4][2], const Unit& u, int wr, int wc, int fr, int fq) const {
        const int row0 = u.pm * BM + wr * 64 + fr; const int col0 = u.pn * HALF + wc * 32 + 8 * fq;
#pragma unroll
        for (int ai = 0; ai < 2; ++ai)
#pragma unroll
            for (int m = 0; m < 4; ++m) { bf16_t* rowp = O + (size_t)(row0 + ai * HALF + m * 16) * ldc + col0;
                f32x4 h[2];
#pragma unroll
                for (int n = 0; n < 2; ++n)
#pragma unroll
                    for (int i = 0; i < 4; ++i) { const float g = acc[ai][0][m][n][i], up = acc[ai][1][m][n][i]; h[n][i] = g * sigmoid_f(g) * up; }
                *(u32x4*)rowp = pack8(h[0], h[1]); }
    }
};
struct EpiIn {
    static constexpr bool PERM = true, AFTER_DRAIN = false;
    bf16_t *QA, *KV, *QB, *KB, *VB, *RB, *GA, *GB; float* ALR; float qa_scale, qb_scale;
    __device__ __forceinline__ void operator()(const f32x4 (&acc)[2][2][4][2], const Unit& u, int wr, int wc, int fr, int fq) const {
        const int pn = u.pn; const int row0 = u.pm * BM + wr * 64 + fr;
        if (pn == 17) {
            if (wc == 0 && fq < 2) {
#pragma unroll
                for (int ai = 0; ai < 2; ++ai)
#pragma unroll
                    for (int m = 0; m < 4; ++m) { float* p = ALR + (size_t)(row0 + ai * HALF + m * 16) * 16 + 8 * fq;
                        *(f32x4*)p = acc[ai][0][m][0]; *(f32x4*)(p + 4) = acc[ai][0][m][1]; }
            }
            return;
        }
        bf16_t* base; int ld, colt; float sc = 1.f; int act = 0;
        if (pn < 2) { base = QA; ld = 512; colt = pn * 256; sc = qa_scale; }
        else if (pn == 2) { base = KV; ld = 256; colt = 0; }
        else if (pn == 3) { base = QB; ld = 256; colt = 0; sc = qb_scale; }
        else if (pn == 4) { base = KB; ld = 256; colt = 0; }
        else if (pn < 7) { base = VB; ld = 512; colt = (pn - 5) * 256; }
        else if (pn < 9) { base = RB; ld = 512; colt = (pn - 7) * 256; act = 2; }
        else if (pn < 13) { base = GA; ld = 1024; colt = (pn - 9) * 256; act = 1; }
        else { base = GB; ld = 1024; colt = (pn - 13) * 256; act = 1; }
        const int col0 = colt + wc * 32 + 8 * fq;
#pragma unroll
        for (int ai = 0; ai < 2; ++ai)
#pragma unroll
            for (int m = 0; m < 4; ++m) { bf16_t* rowp = base + (size_t)(row0 + ai * HALF + m * 16) * ld + col0;
#pragma unroll
                for (int bj = 0; bj < 2; ++bj) { f32x4 v0 = acc[ai][bj][m][0] * sc, v1 = acc[ai][bj][m][1] * sc;
                    if (act != 0) {
#pragma unroll
                        for (int i = 0; i < 4; ++i) { const float s0 = sigmoid_f(v0[i]), s1 = sigmoid_f(v1[i]); v0[i] = (act == 1) ? s0 : v0[i] * s0; v1[i] = (act == 1) ? s1 : v1[i] * s1; }
                    }
                    *(u32x4*)(rowp + bj * HALF) = pack8(v0, v1); } }
    }
};
template <bool SECOND> struct EpiGate {
    static constexpr bool PERM = true, AFTER_DRAIN = false;
    const bf16_t* Gt; bf16_t* O;
    __device__ __forceinline__ void operator()(const f32x4 (&acc)[2][2][4][2], const Unit& u, int wr, int wc, int fr, int fq) const {
        const int row0 = u.pm * BM + wr * 64 + fr; const int col0 = u.pn * BM + wc * 32 + 8 * fq;
#pragma unroll
        for (int ai = 0; ai < 2; ++ai)
#pragma unroll
            for (int m = 0; m < 4; ++m) { const size_t off = (size_t)(row0 + ai * HALF + m * 16) * 1024 + col0;
#pragma unroll
                for (int bj = 0; bj < 2; ++bj) { const u32x4 gw = *(const u32x4*)(Gt + off + bj * HALF);
                    f32x4 v0 = acc[ai][bj][m][0], v1 = acc[ai][bj][m][1];
                    v0[0] *= bf_lo(gw.x); v0[1] *= bf_hi(gw.x); v0[2] *= bf_lo(gw.y); v0[3] *= bf_hi(gw.y);
                    v1[0] *= bf_lo(gw.z); v1[1] *= bf_hi(gw.z); v1[2] *= bf_lo(gw.w); v1[3] *= bf_hi(gw.w);
                    if (SECOND) { const u32x4 pw = *(const u32x4*)(O + off + bj * HALF);
                        v0[0] += bf_lo(pw.x); v0[1] += bf_hi(pw.x); v0[2] += bf_lo(pw.y); v0[3] += bf_hi(pw.y);
                        v1[0] += bf_lo(pw.z); v1[1] += bf_hi(pw.z); v1[2] += bf_lo(pw.w); v1[3] += bf_hi(pw.w); }
                    *(u32x4*)(O + off + bj * HALF) = pack8(v0, v1); } }
    }
};
template <class Epi, class Sched, bool ALIGN_EPI = false, bool SP2 = false>
__device__ __forceinline__ void gemm_phase(PG8_LAS unsigned char* lds, const Gemm g, const Sched& S, const Epi& E) {
    const int tid = threadIdx.x, wid = __builtin_amdgcn_readfirstlane(tid >> 6), lane = tid & 63, wr = wid >> 2, wc = wid & 3, fr = lane & 15, fq = lane >> 4;
    const int K = g.K, nt = K / BK;
    unsigned voffA[2], voffB[2];
#pragma unroll
    for (int i = 0; i < 2; ++i) { int R, C; stage_rc(tid * 16 + i * 8192, R, C); const int Rb = Epi::PERM ? ((R & ~31) + perm32(R & 31)) : R;
        voffA[i] = (unsigned)(R * g.lda + C) * 2u; voffB[i] = (unsigned)(Rb * g.ldb + C) * 2u; }
    const size_t kstep = (size_t)(BK * 2);
    const size_t hsA = (size_t)HALF * g.lda * 2, hsB = (size_t)HALF * g.ldb * 2;
    const size_t tsA = 2 * hsA, tsB = 2 * hsB;
    const unsigned ldsw = (unsigned)wid * 1024u;
    const int aoff = lds_byte(wr * 64 + fr, fq * 8), boff = lds_byte(wc * 32 + fr, fq * 8);
#define PG8_SA(b, h) (((b) * 2 + (h)) * HTB)
#define PG8_SB(b, h) ((4 + (b) * 2 + (h)) * HTB)
#define PG8_STAGE(bufoff, gbase, voff) do { _Pragma("unroll") for (int _i = 0; _i < 2; ++_i) \
        __builtin_amdgcn_global_load_lds((const unsigned*)((const char*)(gbase) + (voff)[_i]), (PG8_LAS unsigned*)(lds + (bufoff) + ldsw + _i * 8192), 16, 0, 0); } while (0)
#define PG8_LDA(dst, b, h) do { _Pragma("unroll") for (int m = 0; m < 4; ++m) _Pragma("unroll") for (int k = 0; k < 2; ++k) dst[m][k] = *(const PG8_LAS bf16x8*)(lds + PG8_SA(b, h) + aoff + m * 2048 + k * 1024); } while (0)
#define PG8_LDB(dst, b, h) do { _Pragma("unroll") for (int n = 0; n < 2; ++n) _Pragma("unroll") for (int k = 0; k < 2; ++k) dst[n][k] = *(const PG8_LAS bf16x8*)(lds + PG8_SB(b, h) + boff + n * 2048 + k * 1024); } while (0)
#define PG8_MMA(ai, bj, At, Bt) do { __builtin_amdgcn_s_setprio(1); _Pragma("unroll") for (int m = 0; m < 4; ++m) _Pragma("unroll") for (int n = 0; n < 2; ++n) _Pragma("unroll") for (int k = 0; k < 2; ++k) \
        acc[ai][bj][m][n] = __builtin_amdgcn_mfma_f32_16x16x32_bf16(Bt[n][k], At[m][k], acc[ai][bj][m][n], 0, 0, 0); __builtin_amdgcn_s_setprio(0); } while (0)
#define PG8_WAIT_V(n) asm volatile("s_waitcnt vmcnt(" #n ")" ::: "memory")
#define PG8_WAIT_L(n) asm volatile("s_waitcnt lgkmcnt(" #n ")" ::: "memory")
#define PG8_BAR __builtin_amdgcn_s_barrier()
#define PG8_SCHED __builtin_amdgcn_sched_barrier(0)
    Unit cur, nxt; int ui = 0;
    if (!S.next(0, cur)) return;
    f32x4 acc[2][2][4][2];
#pragma unroll
    for (int a = 0; a < 2; ++a)
#pragma unroll
        for (int b = 0; b < 2; ++b)
#pragma unroll
            for (int m = 0; m < 4; ++m)
#pragma unroll
                for (int n = 0; n < 2; ++n) acc[a][b][m][n] = (f32x4){0.f, 0.f, 0.f, 0.f};
    bf16x8 At[4][2], B0[2][2], B1[2][2];
    const char* cA = (const char*)g.A + (size_t)cur.pm * tsA; const char* cB = (const char*)g.Bt + (size_t)cur.pn * tsB;
    S.a_ready(cur);
    if constexpr (SP2) {
        PG8_STAGE(PG8_SB(0, 0), cB, voffB); PG8_STAGE(PG8_SB(0, 1), cB + hsB, voffB); PG8_STAGE(PG8_SA(0, 0), cA, voffA); PG8_STAGE(PG8_SA(0, 1), cA + hsA, voffA);
        if (wr == 1) PG8_BAR;
        PG8_WAIT_V(2); PG8_BAR;
        PG8_STAGE(PG8_SB(1, 0), cB + kstep, voffB); PG8_STAGE(PG8_SA(1, 0), cA + kstep, voffA); PG8_STAGE(PG8_SB(1, 1), cB + hsB + kstep, voffB);
        PG8_WAIT_V(6); PG8_BAR;
    } else {
        PG8_STAGE(PG8_SB(0, 0), cB, voffB); PG8_STAGE(PG8_SA(0, 0), cA, voffA); PG8_STAGE(PG8_SB(0, 1), cB + hsB, voffB); PG8_STAGE(PG8_SA(0, 1), cA + hsA, voffA);
        if (wr == 1) PG8_BAR;
        PG8_WAIT_V(4); PG8_BAR;
        PG8_STAGE(PG8_SB(1, 0), cB + kstep, voffB); PG8_STAGE(PG8_SA(1, 0), cA + kstep, voffA); PG8_STAGE(PG8_SB(1, 1), cB + hsB + kstep, voffB);
        PG8_WAIT_V(6); PG8_BAR;
    }
    for (;;) {
        const bool has_next = S.next(ui + 1, nxt);
        const char* nA = has_next ? (const char*)g.A + (size_t)nxt.pm * tsA : cA; const char* nB = has_next ? (const char*)g.Bt + (size_t)nxt.pn * tsB : cB;
        for (int t = 0; t < nt; t += 2) {
            const bool last = (t == nt - 2);
            const char* a1 = cA + (size_t)(t + 1) * kstep;
            const char* a2 = last ? nA : cA + (size_t)(t + 2) * kstep; const char* b2 = last ? nB : cB + (size_t)(t + 2) * kstep;
            const char* a3 = a2 + kstep; const char* b3 = b2 + kstep;
            if (last && has_next) S.a_ready(nxt);
            if constexpr (SP2) {
            PG8_LDB(B0, 0, 0); PG8_LDB(B1, 0, 1); PG8_SCHED; PG8_LDA(At, 0, 0); PG8_STAGE(PG8_SA(1, 1), a1 + hsA, voffA);
            PG8_WAIT_V(8); PG8_WAIT_L(0); PG8_BAR; PG8_MMA(0, 0, At, B0); PG8_MMA(0, 1, At, B1); PG8_BAR; PG8_SCHED;
            PG8_LDA(At, 0, 1); PG8_STAGE(PG8_SB(0, 0), b2, voffB); PG8_STAGE(PG8_SB(0, 1), b2 + hsB, voffB); PG8_STAGE(PG8_SA(0, 0), a2, voffA);
            PG8_WAIT_V(8); PG8_WAIT_L(0); PG8_BAR; PG8_MMA(1, 0, At, B0); PG8_MMA(1, 1, At, B1); PG8_BAR; PG8_SCHED;
            PG8_LDB(B0, 1, 0); PG8_LDB(B1, 1, 1); PG8_SCHED; PG8_LDA(At, 1, 0); PG8_STAGE(PG8_SA(0, 1), a2 + hsA, voffA);
            PG8_WAIT_V(8); PG8_WAIT_L(0); PG8_BAR; PG8_MMA(0, 0, At, B0); PG8_MMA(0, 1, At, B1); PG8_BAR; PG8_SCHED;
            PG8_LDA(At, 1, 1); PG8_STAGE(PG8_SB(1, 0), b3, voffB); PG8_STAGE(PG8_SB(1, 1), b3 + hsB, voffB); PG8_STAGE(PG8_SA(1, 0), a3, voffA);
            PG8_WAIT_V(8); PG8_WAIT_L(0); PG8_BAR; PG8_MMA(1, 0, At, B0); PG8_MMA(1, 1, At, B1); PG8_BAR; PG8_SCHED;
            } else {
            PG8_LDB(B0, 0, 0); PG8_SCHED; PG8_LDA(At, 0, 0); PG8_STAGE(PG8_SA(1, 1), a1 + hsA, voffA);
            PG8_WAIT_L(8); PG8_BAR; PG8_WAIT_L(0); PG8_MMA(0, 0, At, B0); PG8_BAR; PG8_SCHED;
            PG8_LDB(B1, 0, 1); PG8_STAGE(PG8_SB(0, 0), b2, voffB);
            PG8_BAR; PG8_WAIT_L(0); PG8_MMA(0, 1, At, B1); PG8_BAR;
            PG8_LDA(At, 0, 1); PG8_STAGE(PG8_SA(0, 0), a2, voffA);
            PG8_BAR; PG8_WAIT_L(0); PG8_MMA(1, 0, At, B0); PG8_BAR; PG8_SCHED;
            PG8_STAGE(PG8_SB(0, 1), b2 + hsB, voffB);
            PG8_WAIT_V(6); PG8_BAR; PG8_MMA(1, 1, At, B1); PG8_BAR;
            PG8_LDB(B0, 1, 0); PG8_SCHED; PG8_LDA(At, 1, 0); PG8_STAGE(PG8_SA(0, 1), a2 + hsA, voffA);
            PG8_WAIT_L(8); PG8_BAR; PG8_WAIT_L(0); PG8_MMA(0, 0, At, B0); PG8_BAR; PG8_SCHED;
            PG8_LDB(B1, 1, 1); PG8_STAGE(PG8_SB(1, 0), b3, voffB);
            PG8_BAR; PG8_WAIT_L(0); PG8_MMA(0, 1, At, B1); PG8_BAR;
            PG8_LDA(At, 1, 1); PG8_STAGE(PG8_SA(1, 0), a3, voffA);
            PG8_BAR; PG8_WAIT_L(0); PG8_MMA(1, 0, At, B0); PG8_BAR; PG8_SCHED;
            PG8_STAGE(PG8_SB(1, 1), b3 + hsB, voffB);
            PG8_WAIT_V(6); PG8_BAR; PG8_MMA(1, 1, At, B1); PG8_BAR;
            }
        }
        if constexpr (ALIGN_EPI) { if (wr == 0) PG8_BAR; }
        if constexpr (!Epi::AFTER_DRAIN) { E(acc, cur, wr, wc, fr, fq); S.done(cur); }
        if (!has_next) break;
#pragma unroll
        for (int a = 0; a < 2; ++a)
#pragma unroll
            for (int b = 0; b < 2; ++b)
#pragma unroll
                for (int m = 0; m < 4; ++m)
#pragma unroll
                    for (int n = 0; n < 2; ++n) acc[a][b][m][n] = (f32x4){0.f, 0.f, 0.f, 0.f};
        cur = nxt; cA = nA; cB = nB; ++ui;
        if constexpr (ALIGN_EPI) { if (wr == 1) PG8_BAR; }
    }
    PG8_WAIT_V(0);
    if constexpr (!ALIGN_EPI) { if (wr == 0) PG8_BAR; }
    PG8_BAR;
    if constexpr (Epi::AFTER_DRAIN) { E.fused(acc, cur, wr, wc, fr, fq, lds, wid, lane); S.done(cur); }
#undef PG8_SA
#undef PG8_SB
#undef PG8_STAGE
#undef PG8_LDA
#undef PG8_LDB
#undef PG8_MMA
#undef PG8_WAIT_V
#undef PG8_WAIT_L
#undef PG8_BAR
#undef PG8_SCHED
}
}

#ifndef FAST_ATTN
#define FAST_ATTN 1
#endif
constexpr int NWAVES = 8;
#ifndef MK_N_LAUNCHES
#define MK_N_LAUNCHES 1
#endif
constexpr int N_PHASES = 14;
constexpr int N_LAUNCHES = MK_N_LAUNCHES;
static_assert(N_LAUNCHES == 1 || N_LAUNCHES == N_PHASES, "MK_N_LAUNCHES is 1 or N_PHASES");

constexpr int BATCH = 16, SEQ = 2048, D = 1024, FF = 2816;
constexpr int M = BATCH * SEQ;
constexpr int NQH = 8, NKVH = 2, HD = 64, WINDOW = 128;
constexpr int GH = 4, GDK = 64, GDV = 128, GRANK = 16;
constexpr int IN_W = 4368, NIN = 4608;
constexpr float EPS = 1e-6f;
constexpr float LOG2E = 1.4426950408889634f;

constexpr size_t MiB = 1u << 20;
constexpr size_t WS_CTL = 0, CTL_ZERO_BYTES = 1 * MiB;
constexpr size_t WS_W1GU = 2 * MiB, WS_W1D = 13 * MiB, WS_W2GU = 19 * MiB, WS_W2D = 30 * MiB, WS_WIN = 36 * MiB, WS_WPAB = 45 * MiB, WS_WOUT = 47 * MiB;
constexpr size_t WS_HN = 64 * MiB;
constexpr size_t WS_F = 128 * MiB;
constexpr size_t WS_BIG = 192 * MiB;
constexpr size_t WS_QA = WS_BIG, WS_KV = WS_QA + 32 * MiB, WS_QB = WS_KV + 16 * MiB, WS_KB = WS_QB + 16 * MiB, WS_VB = WS_KB + 16 * MiB, WS_RB = WS_VB + 32 * MiB,
                 WS_GA = WS_RB + 32 * MiB, WS_GB = WS_GA + 64 * MiB, WS_ALR = WS_GB + 64 * MiB, WS_END = WS_ALR + 2 * MiB;
constexpr size_t WS_MO = WS_BIG;
static_assert(WS_W1GU + (size_t)2 * FF * D * 2 <= WS_W1D && WS_W1D + (size_t)D * FF * 2 <= WS_W2GU && WS_W2GU + (size_t)2 * FF * D * 2 <= WS_W2D && WS_W2D + (size_t)D * FF * 2 <= WS_WIN &&
              WS_WIN + (size_t)NIN * D * 2 <= WS_WPAB && WS_WPAB + (size_t)D * D * 2 <= WS_WOUT && WS_WOUT + (size_t)D * D * 2 <= WS_HN, "weight map");
static_assert(WS_BIG + (size_t)M * FF * 2 <= 512 * MiB && WS_END <= 512 * MiB, "d_ws map");
constexpr int CW_TMO = 0, CW_CODE = 1;
constexpr int CW_BAR = 4096;

constexpr int RING_OFF = 0, RING_BYTES = 131072;
constexpr int LDSCTL_OFF = RING_BYTES, MISC_OFF = LDSCTL_OFF + 320;
constexpr int LDS_BYTES = 147456;
static_assert(MISC_OFF + 128 <= LDS_BYTES, "LDS map");
#define GAS __attribute__((address_space(1)))
#define LAS __attribute__((address_space(3)))
typedef unsigned short bf16;
typedef unsigned v4u __attribute__((ext_vector_type(4)));
typedef float f32x4 __attribute__((ext_vector_type(4)));
typedef short bf16x8 __attribute__((ext_vector_type(8)));
typedef GAS unsigned gu32;
typedef GAS unsigned long long gu64;
#define RLX_AGENT __ATOMIC_RELAXED, __HIP_MEMORY_SCOPE_AGENT
#define LDS_WAIT() asm volatile("s_waitcnt lgkmcnt(0)" ::: "memory")
#define VM_WAIT() asm volatile("s_waitcnt vmcnt(0)" ::: "memory")
__device__ __forceinline__ unsigned long long rt() { return __builtin_amdgcn_s_memrealtime(); }
__device__ __forceinline__ unsigned f2bf(float f) { unsigned u = __builtin_bit_cast(unsigned, f); return (u + 0x7fffu + ((u >> 16) & 1u)) >> 16; }
__device__ __forceinline__ unsigned pk2(float lo, float hi) { return f2bf(lo) | (f2bf(hi) << 16); }
#define XB_TMO      128
#define XB_XCNT(j)  (256  + 64 * (j))
#define XB_XSUB(j)  (1280 + 64 * (j))
#define XB_XGEN(j)  (2304 + 64 * (j))
#define XB_TOP      3328
#define XB_TOPGEN   3392
#define XCD_BAR_WORDS 3456
#define XB_SPIN_CAP (1u << 18)

__device__ __forceinline__ unsigned xb_ld(unsigned* p)              { return __hip_atomic_load(p, __ATOMIC_RELAXED, __HIP_MEMORY_SCOPE_AGENT); }
__device__ __forceinline__ unsigned xb_add(unsigned* p, unsigned v) { return __hip_atomic_fetch_add(p, v, __ATOMIC_RELAXED, __HIP_MEMORY_SCOPE_AGENT); }
__device__ __forceinline__ unsigned xb_xcc_id() { return (unsigned)__builtin_amdgcn_s_getreg((3 << 11) | 20) & 0xFu; }
#define XB_SPIN(cond, bar) do { unsigned _sp = 0; while (cond) { __builtin_amdgcn_s_sleep(1); \
    if ((++_sp & 255u) == 0u) { if (xb_ld(&(bar)[XB_TMO])) break; if (_sp > XB_SPIN_CAP) { atomicAdd(&(bar)[XB_TMO], 1u); break; } } } } while (0)

struct XcdBarrier {
    unsigned* bar; unsigned x;
    volatile LAS unsigned* st;
};

__device__ __forceinline__ XcdBarrier xcd_barrier_post(unsigned* bar, volatile LAS unsigned* st) {
    XcdBarrier b; b.bar = bar; b.x = xb_xcc_id(); b.st = st;
    if (threadIdx.x == 0) (void)xb_add(&bar[XB_XCNT(b.x)], 1u);
    return b;
}
__device__ __forceinline__ void xcd_barrier_complete(unsigned* bar, unsigned x, unsigned& nloc, unsigned& nx) {
    const unsigned G = gridDim.x * gridDim.y * gridDim.z;
    unsigned sum, cnt, mine, sp = 0u;
    for (;;) {
        sum = 0u; cnt = 0u; mine = 0u;
#pragma unroll
        for (unsigned j = 0; j < 16; ++j) { const unsigned c = xb_ld(&bar[XB_XCNT(j)]); sum += c; cnt += (c > 0u) ? 1u : 0u; mine = (j == x) ? c : mine; }
        if (sum == G) break;
        __builtin_amdgcn_s_sleep(1);
        if ((++sp & 255u) == 0u) { if (xb_ld(&bar[XB_TMO])) break; if (sp > XB_SPIN_CAP) { atomicAdd(&bar[XB_TMO], 1u); break; } }
    }
    nloc = mine > 0u ? mine : 1u; nx = cnt > 0u ? cnt : 1u;
}

__device__ __forceinline__ void xcd_barrier(const XcdBarrier& b) {
    asm volatile("s_waitcnt vmcnt(0)" ::: "memory");
    __syncthreads();
    if (threadIdx.x == 0) {
        unsigned* bar = b.bar;
        __builtin_amdgcn_s_waitcnt(0);
        unsigned nloc = b.st[0], nx = b.st[1];
        if (nloc == 0u) { xcd_barrier_complete(bar, b.x, nloc, nx); b.st[0] = nloc; b.st[1] = nx; }
        const unsigned old = xb_add(&bar[XB_XSUB(b.x)], 1u);
        const unsigned gen = old / nloc;
        if (old + 1u == (gen + 1u) * nloc) {
            __builtin_amdgcn_fence(__ATOMIC_RELEASE, "agent");
            asm volatile("s_waitcnt vmcnt(0)" ::: "memory");
            const unsigned og = xb_add(&bar[XB_TOP], 1u);
            const unsigned tg = og / nx;
            if (og + 1u == (tg + 1u) * nx) xb_add(&bar[XB_TOPGEN], 1u);
            else XB_SPIN(xb_ld(&bar[XB_TOPGEN]) == tg, bar);
            __builtin_amdgcn_fence(__ATOMIC_ACQUIRE, "agent");
            xb_add(&bar[XB_XGEN(b.x)], 1u);
            asm volatile("s_waitcnt vmcnt(0)" ::: "memory");
        } else {
            XB_SPIN(xb_ld(&bar[XB_XGEN(b.x)]) == gen, bar);
            __builtin_amdgcn_fence(__ATOMIC_ACQUIRE, "agent");
            asm volatile("s_waitcnt vmcnt(0)" ::: "memory");
        }
    }
    __syncthreads();
}

struct Frame {
    LAS unsigned char* lds;
    volatile LAS unsigned* MISC;
    gu32* ctl;
    int tid, lane, wave;
    int vcu, G;
    const float* x; float* out;
    const float *rel_bias, *f1_pre_g, *f1_wg, *f1_wu, *f1_wd, *f1_post_g, *mix_pre_g, *w_in, *w_alpha, *b_alpha, *sinks, *gla_g, *w_pa, *w_pb, *w_out, *mix_post_g,
                *f2_pre_g, *f2_wg, *f2_wu, *f2_wd, *f2_post_g;
    bf16 *W1GU, *W1D, *W2GU, *W2D, *WIN, *WPAB, *WOUT;
    bf16 *HN, *FB, *HB, *QA, *KV, *QB, *KB, *VB, *RB, *GA, *GB, *MO;
    float *ALR, *OG;
};

__device__ __forceinline__ float wave_sum(float v) {
#pragma unroll
    for (int o = 1; o < 64; o <<= 1) v += __shfl_xor(v, o);
    return v;
}
__device__ __forceinline__ void p0_transpose_item(const float* W, int ldw, int k0, int n0, int nvalid, bf16* WT, int ldt, int drow0, int kd0, LAS float* scr, int lane) {
#pragma unroll 8
    for (int i = 0; i < 32; ++i) { const int kk = 2 * i + (lane >> 5); const int nn = lane & 31; scr[kk * 33 + nn] = (nn < nvalid) ? W[(size_t)(k0 + kk) * ldw + n0 + nn] : 0.f; }
    LDS_WAIT(); asm volatile("" ::: "memory");
    const int c = lane & 7;
#pragma unroll
    for (int j = 0; j < 4; ++j) { const int n = (lane >> 3) + 8 * j; const LAS float* s = scr + (8 * c) * 33 + n;
        v4u o; o.x = pk2(s[0 * 33], s[1 * 33]); o.y = pk2(s[2 * 33], s[3 * 33]); o.z = pk2(s[4 * 33], s[5 * 33]); o.w = pk2(s[6 * 33], s[7 * 33]);
        *(GAS v4u*)(WT + (size_t)(drow0 + n) * ldt + kd0 + 8 * c) = o; }
    LDS_WAIT(); asm volatile("" ::: "memory");
}
__device__ __forceinline__ void p0_item_gu(const float* Wg, const float* Wu, bf16* WT, int r, LAS float* scr, int lane) {
    constexpr int NB = FF / 32;
    const int which = r / (16 * NB); r -= which * 16 * NB; const int kb = r / NB, nb = r % NB, n0 = 32 * nb;
    const int drow = 256 * (n0 / 128) + (n0 % 128) + which * 128;
    p0_transpose_item(which ? Wu : Wg, FF, 64 * kb, n0, 32, WT, D, drow, 64 * kb, scr, lane);
}
__device__ __forceinline__ void p0_item_down(const float* Wd, bf16* WT, int r, LAS float* scr, int lane) {
    const int kb = r / 32, nb = r % 32;
    p0_transpose_item(Wd, D, 64 * kb, 32 * nb, 32, WT, FF, 32 * nb, 64 * kb, scr, lane);
}
__device__ __forceinline__ void p0_prologue(Frame& F) {
    LAS float* scr = (LAS float*)(F.lds + RING_OFF + F.wave * 16384);
    const int gw = F.vcu * NWAVES + F.wave, NGW = F.G * NWAVES;
    constexpr int I_GU = 2 * 16 * (FF / 32), I_DN = (FF / 64) * (D / 32), I_IN = 16 * 137, I_P = 8 * 32, I_O = 16 * 32;
    constexpr int NITEMS = 2 * I_GU + 2 * I_DN + I_IN + 2 * I_P + I_O;
    for (int it = gw; it < NITEMS; it += NGW) {
        int r = it;
        if (r < I_GU) { p0_item_gu(F.f1_wg, F.f1_wu, F.W1GU, r, scr, F.lane); continue; } r -= I_GU;
        if (r < I_GU) { p0_item_gu(F.f2_wg, F.f2_wu, F.W2GU, r, scr, F.lane); continue; } r -= I_GU;
        if (r < I_DN) { p0_item_down(F.f1_wd, F.W1D, r, scr, F.lane); continue; } r -= I_DN;
        if (r < I_DN) { p0_item_down(F.f2_wd, F.W2D, r, scr, F.lane); continue; } r -= I_DN;
        if (r < I_IN) {
            const int kb = r / 137, nb = r % 137;
            if (nb < 136) { const int drow = 32 * nb; const int scol = drow < 2304 ? drow : drow + 16; p0_transpose_item(F.w_in, IN_W, 64 * kb, scol, 32, F.WIN, D, drow, 64 * kb, scr, F.lane); }
            else p0_transpose_item(F.w_in, IN_W, 64 * kb, 2304, 16, F.WIN, D, 4352, 64 * kb, scr, F.lane);
            continue; } r -= I_IN;
        if (r < I_P) { const int kb = r / 32, nb = r % 32; p0_transpose_item(F.w_pa, D, 64 * kb, 32 * nb, 32, F.WPAB, D, 32 * nb, 64 * kb, scr, F.lane); continue; } r -= I_P;
        if (r < I_P) { const int kb = r / 32, nb = r % 32; p0_transpose_item(F.w_pb, D, 64 * kb, 32 * nb, 32, F.WPAB, D, 32 * nb, 512 + 64 * kb, scr, F.lane); continue; } r -= I_P;
        { const int kb = r / 32, nb = r % 32; p0_transpose_item(F.w_out, D, 64 * kb, 32 * nb, 32, F.WOUT, D, 32 * nb, 64 * kb, scr, F.lane); }
    }
    for (int rr = gw; rr < 224; rr += NGW) { GAS v4u* o = (GAS v4u*)(F.WIN + (size_t)(4384 + rr) * D) + F.lane; o[0] = (v4u){0u, 0u, 0u, 0u}; o[64] = (v4u){0u, 0u, 0u, 0u}; }
    {
        f32x4 g[4];
#pragma unroll
        for (int j = 0; j < 4; ++j) g[j] = ((const GAS f32x4*)F.f1_pre_g)[F.lane + 64 * j];
        for (int m = gw; m < M; m += NGW) {
            const GAS f32x4* xr = (const GAS f32x4*)(F.x + (size_t)m * D) + F.lane;
            f32x4 v[4]; float s = 0.f;
#pragma unroll
            for (int j = 0; j < 4; ++j) { v[j] = xr[64 * j]; s += (v[j].x * v[j].x + v[j].y * v[j].y) + (v[j].z * v[j].z + v[j].w * v[j].w); }
            const float rs = 1.f / sqrtf(wave_sum(s) * (1.f / D) + EPS);
            GAS unsigned long long* o8 = (GAS unsigned long long*)(F.HN + (size_t)m * D) + F.lane;
#pragma unroll
            for (int j = 0; j < 4; ++j) { const f32x4 y = v[j] * rs * g[j]; o8[64 * j] = (unsigned long long)pk2(y.x, y.y) | ((unsigned long long)pk2(y.z, y.w) << 32); }
        }
    }
}
template <bool HAS_HN> __device__ __forceinline__ void thin_norm(Frame& F, const bf16* fin, const float* xi, float* xo, float coef, const float* gpost, bf16* hn, const float* gpre) {
    const int gw = F.vcu * NWAVES + F.wave, NGW = F.G * NWAVES;
    f32x4 gp[4], gq[4];
#pragma unroll
    for (int j = 0; j < 4; ++j) { gp[j] = ((const GAS f32x4*)gpost)[F.lane + 64 * j] * coef; if (HAS_HN) gq[j] = ((const GAS f32x4*)gpre)[F.lane + 64 * j]; }
    for (int m = gw; m < M; m += NGW) {
        const GAS unsigned long long* fr = (const GAS unsigned long long*)(fin + (size_t)m * D) + F.lane;
        const GAS f32x4* xr = (const GAS f32x4*)(xi + (size_t)m * D) + F.lane;
        f32x4 f[4], xv[4]; float s = 0.f;
#pragma unroll
        for (int j = 0; j < 4; ++j) { const unsigned long long w = fr[64 * j]; const unsigned lo = (unsigned)w, hi = (unsigned)(w >> 32);
            f[j] = (f32x4){pg8::bf_lo(lo), pg8::bf_hi(lo), pg8::bf_lo(hi), pg8::bf_hi(hi)}; xv[j] = xr[64 * j];
            s += (f[j].x * f[j].x + f[j].y * f[j].y) + (f[j].z * f[j].z + f[j].w * f[j].w); }
        const float rs = 1.f / sqrtf(wave_sum(s) * (1.f / D) + EPS);
        float s2 = 0.f;
        GAS f32x4* xw = (GAS f32x4*)(xo + (size_t)m * D) + F.lane;
#pragma unroll
        for (int j = 0; j < 4; ++j) { xv[j] = xv[j] + f[j] * rs * gp[j]; xw[64 * j] = xv[j]; s2 += (xv[j].x * xv[j].x + xv[j].y * xv[j].y) + (xv[j].z * xv[j].z + xv[j].w * xv[j].w); }
        if (HAS_HN) {
            const float rs2 = 1.f / sqrtf(wave_sum(s2) * (1.f / D) + EPS);
            GAS unsigned long long* o8 = (GAS unsigned long long*)(hn + (size_t)m * D) + F.lane;
#pragma unroll
            for (int j = 0; j < 4; ++j) { const f32x4 y = xv[j] * rs2 * gq[j]; o8[64 * j] = (unsigned long long)pk2(y.x, y.y) | ((unsigned long long)pk2(y.z, y.w) << 32); }
        }
    }
}

__device__ __forceinline__ int t5_bucket(int d) {
    if (d < 16) return d;
    return 16 + (d >= 19) + (d >= 21) + (d >= 24) + (d >= 27) + (d >= 31) + (d >= 35) + (d >= 40) + (d >= 46) + (d >= 52) + (d >= 59) + (d >= 67) + (d >= 77) + (d >= 87) + (d >= 99) + (d >= 113);
}
__device__ __forceinline__ void gla_naive(Frame& F) {
    LAS float* L = (LAS float*)(F.lds + RING_OFF);
    LAS float* qs = L;
    LAS float* ks = L + 4096;
    LAS float* adec = L + 8192;
    LAS float* vs = L + 12288;
    LAS float* os = L + 14336;
    for (int u = blockIdx.x; u < BATCH * GH * 4; u += F.G) {
        const int b = u / 16, h = (u / 4) % 4, e0 = (u % 4) * 32;
        float S[32];
#pragma unroll
        for (int i = 0; i < 32; ++i) S[i] = 0.f;
        for (int c = 0; c < SEQ / 64; ++c) {
            const int tok0 = b * SEQ + c * 64;
            {
                const int tt = F.tid >> 3, d0 = (F.tid & 7) * 8; const size_t tok = (size_t)tok0 + tt;
                const v4u qw = *(const GAS v4u*)(F.QB + tok * 256 + h * 64 + d0), kw = *(const GAS v4u*)(F.KB + tok * 256 + h * 64 + d0);
                LAS float* qd = qs + tt * 64 + d0; LAS float* kd = ks + tt * 64 + d0;
                qd[0] = pg8::bf_lo(qw.x); qd[1] = pg8::bf_hi(qw.x); qd[2] = pg8::bf_lo(qw.y); qd[3] = pg8::bf_hi(qw.y); qd[4] = pg8::bf_lo(qw.z); qd[5] = pg8::bf_hi(qw.z); qd[6] = pg8::bf_lo(qw.w); qd[7] = pg8::bf_hi(qw.w);
                kd[0] = pg8::bf_lo(kw.x); kd[1] = pg8::bf_hi(kw.x); kd[2] = pg8::bf_lo(kw.y); kd[3] = pg8::bf_hi(kw.y); kd[4] = pg8::bf_lo(kw.z); kd[5] = pg8::bf_hi(kw.z); kd[6] = pg8::bf_lo(kw.w); kd[7] = pg8::bf_hi(kw.w);
                float z[8];
#pragma unroll
                for (int i = 0; i < 8; ++i) z[i] = F.b_alpha[h * 64 + d0 + i];
#pragma unroll
                for (int r = 0; r < GRANK; ++r) { const float a = F.ALR[tok * 16 + r];
#pragma unroll
                    for (int i = 0; i < 8; ++i) z[i] += a * F.w_alpha[r * 256 + h * 64 + d0 + i]; }
#pragma unroll
                for (int i = 0; i < 8; ++i) { const float ls = fminf(z[i], 0.f) - log1pf(expf(-fabsf(z[i]))); adec[tt * 64 + d0 + i] = expf(ls * (1.f / 16.f)); }
                const int vt = F.tid >> 3, ve = (F.tid & 7) * 4;
                const unsigned long long vw = *(const GAS unsigned long long*)(F.VB + ((size_t)tok0 + vt) * 512 + h * 128 + e0 + ve);
                const unsigned vlo = (unsigned)vw, vhi = (unsigned)(vw >> 32);
                LAS float* vd = vs + vt * 32 + ve; vd[0] = pg8::bf_lo(vlo); vd[1] = pg8::bf_hi(vlo); vd[2] = pg8::bf_lo(vhi); vd[3] = pg8::bf_hi(vhi);
            }
            __syncthreads();
            if (F.wave == 0) {
                const int e = F.lane & 31, hf = F.lane >> 5;
                for (int t = 0; t < 64; ++t) {
                    const float v = vs[t * 32 + e]; float acc = 0.f;
                    const LAS float* ap = adec + t * 64 + hf * 32; const LAS float* kp = ks + t * 64 + hf * 32; const LAS float* qp = qs + t * 64 + hf * 32;
#pragma unroll
                    for (int dd = 0; dd < 32; ++dd) { S[dd] = ap[dd] * S[dd] + kp[dd] * v; acc += qp[dd] * S[dd]; }
                    acc += __shfl_xor(acc, 32);
                    if (hf == 0) os[t * 32 + e] = acc;
                }
            }
            __syncthreads();
            { const int vt = F.tid >> 3, ve = (F.tid & 7) * 4; const LAS float* od = os + vt * 32 + ve;
              *(GAS f32x4*)(F.OG + ((size_t)tok0 + vt) * 512 + h * 128 + e0 + ve) = (f32x4){od[0], od[1], od[2], od[3]}; }
        }
    }
}
__device__ __forceinline__ void attn_naive(Frame& F) {
    LAS float* btab = (LAS float*)(F.lds + RING_OFF) + 16384;
    __syncthreads();
    for (int i = F.tid; i < NQH * 128; i += NWAVES * 64) { const int h = i >> 7, d = i & 127; btab[i] = F.rel_bias[t5_bucket(d) * NQH + h] * LOG2E; }
    __syncthreads();
    for (int item = blockIdx.x * (NWAVES * 64) + F.tid; item < M * NQH; item += F.G * NWAVES * 64) {
        const int h = item / M, tok = item % M, p = tok % SEQ, kvh = h / (NQH / NKVH);
        float q[64], o[64];
        { const GAS v4u* qp = (const GAS v4u*)(F.QA + (size_t)tok * 512 + h * 64);
#pragma unroll
          for (int j = 0; j < 8; ++j) { const v4u w = qp[j]; q[8 * j + 0] = pg8::bf_lo(w.x); q[8 * j + 1] = pg8::bf_hi(w.x); q[8 * j + 2] = pg8::bf_lo(w.y); q[8 * j + 3] = pg8::bf_hi(w.y);
              q[8 * j + 4] = pg8::bf_lo(w.z); q[8 * j + 5] = pg8::bf_hi(w.z); q[8 * j + 6] = pg8::bf_lo(w.w); q[8 * j + 7] = pg8::bf_hi(w.w); } }
#pragma unroll
        for (int j = 0; j < 64; ++j) o[j] = 0.f;
        float mrun = F.sinks[h] * LOG2E, l = 1.f;
        const int nd = p < WINDOW - 1 ? p : WINDOW - 1;
        for (int d = 0; d <= nd; ++d) {
            const GAS v4u* kp = (const GAS v4u*)(F.KV + (size_t)(tok - d) * 256 + kvh * 64);
            float s = 0.f;
#pragma unroll
            for (int j = 0; j < 8; ++j) { const v4u w = kp[j];
                s += q[8 * j + 0] * pg8::bf_lo(w.x) + q[8 * j + 1] * pg8::bf_hi(w.x) + q[8 * j + 2] * pg8::bf_lo(w.y) + q[8 * j + 3] * pg8::bf_hi(w.y)
                   + q[8 * j + 4] * pg8::bf_lo(w.z) + q[8 * j + 5] * pg8::bf_hi(w.z) + q[8 * j + 6] * pg8::bf_lo(w.w) + q[8 * j + 7] * pg8::bf_hi(w.w); }
            s += btab[h * 128 + d];
            const float mn = fmaxf(mrun, s), al = exp2f(mrun - mn), pe = exp2f(s - mn);
            l = l * al + pe; mrun = mn;
            const GAS v4u* vp = (const GAS v4u*)(F.KV + (size_t)(tok - d) * 256 + 128 + kvh * 64);
#pragma unroll
            for (int j = 0; j < 8; ++j) { const v4u w = vp[j];
                o[8 * j + 0] = o[8 * j + 0] * al + pe * pg8::bf_lo(w.x); o[8 * j + 1] = o[8 * j + 1] * al + pe * pg8::bf_hi(w.x);
                o[8 * j + 2] = o[8 * j + 2] * al + pe * pg8::bf_lo(w.y); o[8 * j + 3] = o[8 * j + 3] * al + pe * pg8::bf_hi(w.y);
                o[8 * j + 4] = o[8 * j + 4] * al + pe * pg8::bf_lo(w.z); o[8 * j + 5] = o[8 * j + 5] * al + pe * pg8::bf_hi(w.z);
                o[8 * j + 6] = o[8 * j + 6] * al + pe * pg8::bf_lo(w.w); o[8 * j + 7] = o[8 * j + 7] * al + pe * pg8::bf_hi(w.w); }
        }
        const float il = 1.f / l;
        GAS v4u* yp = (GAS v4u*)(F.HN + (size_t)tok * D + h * 64);
#pragma unroll
        for (int j = 0; j < 8; ++j) { v4u w; w.x = pk2(o[8 * j + 0] * il, o[8 * j + 1] * il); w.y = pk2(o[8 * j + 2] * il, o[8 * j + 3] * il); w.z = pk2(o[8 * j + 4] * il, o[8 * j + 5] * il); w.w = pk2(o[8 * j + 6] * il, o[8 * j + 7] * il); yp[j] = w; }
    }
}
__device__ __forceinline__ void gla_post(Frame& F) {
    const int gw = F.vcu * NWAVES + F.wave, NGW = F.G * NWAVES;
    const int e = (F.lane & 15) * 8;
    const f32x4 g0 = *(const GAS f32x4*)(F.gla_g + e), g1 = *(const GAS f32x4*)(F.gla_g + e + 4);
    for (int m = gw; m < M; m += NGW) {
        const GAS f32x4* op = (const GAS f32x4*)(F.OG + (size_t)m * 512 + F.lane * 8);
        const f32x4 a = op[0], b = op[1];
        float s = (a.x * a.x + a.y * a.y) + (a.z * a.z + a.w * a.w) + (b.x * b.x + b.y * b.y) + (b.z * b.z + b.w * b.w);
        s += __shfl_xor(s, 1); s += __shfl_xor(s, 2); s += __shfl_xor(s, 4); s += __shfl_xor(s, 8);
        const float rs = 1.f / sqrtf(s * (1.f / GDV) + EPS);
        const v4u rw = *(const GAS v4u*)(F.RB + (size_t)m * 512 + F.lane * 8);
        const f32x4 ya = a * rs * g0, yb = b * rs * g1;
        v4u w; w.x = pk2(ya.x * pg8::bf_lo(rw.x), ya.y * pg8::bf_hi(rw.x)); w.y = pk2(ya.z * pg8::bf_lo(rw.y), ya.w * pg8::bf_hi(rw.y));
        w.z = pk2(yb.x * pg8::bf_lo(rw.z), yb.y * pg8::bf_hi(rw.z)); w.w = pk2(yb.z * pg8::bf_lo(rw.w), yb.w * pg8::bf_hi(rw.w));
        *(GAS v4u*)(F.HN + (size_t)m * D + 512 + F.lane * 8) = w;
    }
}


namespace mix {
typedef short bf16x8 __attribute__((ext_vector_type(8)));
typedef short s16x4 __attribute__((ext_vector_type(4)));
typedef float f32x16 __attribute__((ext_vector_type(16)));
typedef float f32x2_t __attribute__((ext_vector_type(2)));
typedef __bf16 bf16x2_t __attribute__((ext_vector_type(2)));
#define MIX_DI __device__ __forceinline__
#define MFMA32(a, b, c) __builtin_amdgcn_mfma_f32_32x32x16_bf16((a), (b), (c), 0, 0, 0)
MIX_DI unsigned cvtpk(float lo, float hi) { f32x2_t v = {lo, hi}; bf16x2_t b = __builtin_convertvector(v, bf16x2_t); return __builtin_bit_cast(unsigned, b); }
MIX_DI int crow(int r, int hi) { return (r & 3) + 8 * (r >> 2) + 4 * hi; }
template <int S8> MIX_DI bf16x8 pack8(const f32x16& x) {
    v4u p; p.x = cvtpk(x[8 * S8 + 0], x[8 * S8 + 1]); p.y = cvtpk(x[8 * S8 + 2], x[8 * S8 + 3]); p.z = cvtpk(x[8 * S8 + 4], x[8 * S8 + 5]); p.w = cvtpk(x[8 * S8 + 6], x[8 * S8 + 7]);
    return __builtin_bit_cast(bf16x8, p);
}
MIX_DI bf16x8 join8(const s16x4 lo, const s16x4 hi) { return __builtin_shufflevector(lo, hi, 0, 1, 2, 3, 4, 5, 6, 7); }
MIX_DI float ex2(float x) { return __builtin_amdgcn_exp2f(x); }

constexpr int ATT_KT = 0, ATT_KP = 144;
constexpr int ATT_VT = 27648, ATT_VP = 392;
constexpr int ATT_BT = 53248;
constexpr int ATT_END = ATT_BT + 8 * 192 * 4;
MIX_DI void attn_bias_table(Frame& F) {
    LAS float* BT = (LAS float*)(F.lds + RING_OFF + ATT_BT);
    for (int i = F.tid; i < NQH * 192; i += NWAVES * 64) { const int h = i / 192, dist = i % 192 - 32;
        BT[i] = (dist >= 0 && dist < WINDOW) ? F.rel_bias[t5_bucket(dist) * NQH + h] * LOG2E : -__builtin_inff(); }
}
MIX_DI void attn_unit(Frame& F, int b, int kvh, int qt) {
    LAS unsigned char* KT = F.lds + RING_OFF + ATT_KT; LAS unsigned char* VT = F.lds + RING_OFF + ATT_VT; const LAS float* BT = (const LAS float*)(F.lds + RING_OFF + ATT_BT);
    const int p0 = qt * 64, kt0 = p0 - 128; const size_t rowbase = (size_t)b * SEQ;
#pragma unroll
    for (int i = 0; i < 3; ++i) { const int c = F.tid + 512 * i, row = c >> 3, ch = c & 7, kp = kt0 + row;
        v4u kw = (v4u){0u, 0u, 0u, 0u}, vw = (v4u){0u, 0u, 0u, 0u};
        if (kp >= 0) { const bf16* src = F.KV + (rowbase + kp) * 256 + kvh * 64 + ch * 8; kw = *(const GAS v4u*)src; vw = *(const GAS v4u*)(src + 128); }
        *(LAS v4u*)(KT + row * ATT_KP + ch * 16) = kw;
        LAS unsigned short* vt = (LAS unsigned short*)(VT + (ch * 8) * ATT_VP) + row;
        vt[0 * (ATT_VP / 2)] = (unsigned short)(vw.x & 0xffffu); vt[1 * (ATT_VP / 2)] = (unsigned short)(vw.x >> 16);
        vt[2 * (ATT_VP / 2)] = (unsigned short)(vw.y & 0xffffu); vt[3 * (ATT_VP / 2)] = (unsigned short)(vw.y >> 16);
        vt[4 * (ATT_VP / 2)] = (unsigned short)(vw.z & 0xffffu); vt[5 * (ATT_VP / 2)] = (unsigned short)(vw.z >> 16);
        vt[6 * (ATT_VP / 2)] = (unsigned short)(vw.w & 0xffffu); vt[7 * (ATT_VP / 2)] = (unsigned short)(vw.w >> 16); }
    const int g = F.wave >> 1, half = F.wave & 1, hq = kvh * (NQH / NKVH) + g, jl = F.lane & 31, hh = F.lane >> 5;
    const size_t qrow = rowbase + p0 + 32 * half + jl;
    bf16x8 qf[4];
    { const bf16* qp = F.QA + qrow * 512 + hq * 64 + 8 * hh;
#pragma unroll
      for (int ks = 0; ks < 4; ++ks) qf[ks] = *(const GAS bf16x8*)(qp + 16 * ks); }
    __syncthreads();
    f32x16 S[5];
#pragma unroll
    for (int bi = 0; bi < 5; ++bi) { const int blk = half + bi;
#pragma unroll
        for (int r = 0; r < 16; ++r) { const int i = crow(r, hh); float c = BT[hq * 192 + 160 - 32 * bi + jl - i]; if (kt0 < 0 && kt0 + 32 * blk + i < 0) c = -__builtin_inff(); S[bi][r] = c; }
#pragma unroll
        for (int ks = 0; ks < 4; ++ks) { const bf16x8 kf = *(const LAS bf16x8*)(KT + (32 * blk + jl) * ATT_KP + (2 * ks + hh) * 16); S[bi] = MFMA32(kf, qf[ks], S[bi]); } }
    const float sk = F.sinks[hq] * LOG2E;
    float m = sk;
#pragma unroll
    for (int bi = 0; bi < 5; ++bi)
#pragma unroll
        for (int r = 0; r < 16; ++r) m = fmaxf(m, S[bi][r]);
    m = fmaxf(m, __shfl_xor(m, 32));
    float l = 0.f;
#pragma unroll
    for (int bi = 0; bi < 5; ++bi)
#pragma unroll
        for (int r = 0; r < 16; ++r) { const float p = ex2(S[bi][r] - m); S[bi][r] = p; l += p; }
    l += __shfl_xor(l, 32); l += ex2(sk - m);
    f32x16 O0, O1;
#pragma unroll
    for (int r = 0; r < 16; ++r) { O0[r] = 0.f; O1[r] = 0.f; }
#define ATT_PV(bi, s2) do { const bf16x8 pb = pack8<s2>(S[bi]); const int ko = (32 * (half + bi) + 16 * s2 + 4 * hh) * 2; \
        const LAS unsigned char* v0 = VT + jl * ATT_VP + ko; const LAS unsigned char* v1 = VT + (32 + jl) * ATT_VP + ko; \
        O0 = MFMA32(join8(*(const LAS s16x4*)v0, *(const LAS s16x4*)(v0 + 16)), pb, O0); O1 = MFMA32(join8(*(const LAS s16x4*)v1, *(const LAS s16x4*)(v1 + 16)), pb, O1); } while (0)
    ATT_PV(0, 0); ATT_PV(0, 1); ATT_PV(1, 0); ATT_PV(1, 1); ATT_PV(2, 0); ATT_PV(2, 1); ATT_PV(3, 0); ATT_PV(3, 1); ATT_PV(4, 0); ATT_PV(4, 1);
#undef ATT_PV
    const float il = 1.f / l;
    bf16* yp = F.HN + qrow * D + hq * 64 + 4 * hh;
#pragma unroll
    for (int gq = 0; gq < 4; ++gq) {
        *(GAS unsigned long long*)(yp + 8 * gq) = (unsigned long long)cvtpk(O0[4 * gq] * il, O0[4 * gq + 1] * il) | ((unsigned long long)cvtpk(O0[4 * gq + 2] * il, O0[4 * gq + 3] * il) << 32);
        *(GAS unsigned long long*)(yp + 32 + 8 * gq) = (unsigned long long)cvtpk(O1[4 * gq] * il, O1[4 * gq + 1] * il) | ((unsigned long long)cvtpk(O1[4 * gq + 2] * il, O1[4 * gq + 3] * il) << 32); }
    __syncthreads();
}
}

struct Args { const float* in[22]; float* out; unsigned char* ws; int ph_lo, ph_hi; };
__global__ void __launch_bounds__(NWAVES * 64, 2) mk_fwd(Args args) {
    extern __shared__ __attribute__((aligned(16))) unsigned char lds[];
    Frame F;
    F.lds = (LAS unsigned char*)lds;
    F.MISC = (volatile LAS unsigned*)(F.lds + MISC_OFF);
    F.tid = threadIdx.x; F.lane = F.tid & 63; F.wave = __builtin_amdgcn_readfirstlane(F.tid >> 6);
    F.G = gridDim.x; { const int bx = blockIdx.x; F.vcu = (F.G % 8 == 0) ? (bx % 8) * (F.G / 8) + bx / 8 : bx; }
    unsigned char* ws = args.ws;
    F.ctl = (gu32*)(ws + WS_CTL);
    F.x = args.in[0]; F.rel_bias = args.in[1]; F.f1_pre_g = args.in[2]; F.f1_wg = args.in[3]; F.f1_wu = args.in[4]; F.f1_wd = args.in[5]; F.f1_post_g = args.in[6];
    F.mix_pre_g = args.in[7]; F.w_in = args.in[8]; F.w_alpha = args.in[9]; F.b_alpha = args.in[10]; F.sinks = args.in[11]; F.gla_g = args.in[12];
    F.w_pa = args.in[13]; F.w_pb = args.in[14]; F.w_out = args.in[15]; F.mix_post_g = args.in[16];
    F.f2_pre_g = args.in[17]; F.f2_wg = args.in[18]; F.f2_wu = args.in[19]; F.f2_wd = args.in[20]; F.f2_post_g = args.in[21];
    F.out = args.out;
    F.W1GU = (bf16*)(ws + WS_W1GU); F.W1D = (bf16*)(ws + WS_W1D); F.W2GU = (bf16*)(ws + WS_W2GU); F.W2D = (bf16*)(ws + WS_W2D);
    F.WIN = (bf16*)(ws + WS_WIN); F.WPAB = (bf16*)(ws + WS_WPAB); F.WOUT = (bf16*)(ws + WS_WOUT);
    F.HN = (bf16*)(ws + WS_HN); F.FB = (bf16*)(ws + WS_F); F.HB = (bf16*)(ws + WS_BIG);
    F.QA = (bf16*)(ws + WS_QA); F.KV = (bf16*)(ws + WS_KV); F.QB = (bf16*)(ws + WS_QB); F.KB = (bf16*)(ws + WS_KB); F.VB = (bf16*)(ws + WS_VB); F.RB = (bf16*)(ws + WS_RB);
    F.GA = (bf16*)(ws + WS_GA); F.GB = (bf16*)(ws + WS_GB); F.MO = (bf16*)(ws + WS_MO);
    F.ALR = (float*)(ws + WS_ALR); F.OG = (float*)(ws + WS_F);
    for (int u = F.tid; u < (LDS_BYTES - LDSCTL_OFF) / 4; u += NWAVES * 64) ((LAS unsigned*)(F.lds + LDSCTL_OFF))[u] = 0u;
    __syncthreads();
    XcdBarrier bar; bar.bar = (unsigned*)(F.ctl + CW_BAR); bar.x = 0; bar.st = nullptr;
    if (N_LAUNCHES == 1) bar = xcd_barrier_post((unsigned*)(F.ctl + CW_BAR), F.MISC + 8);
#define GRID_BAR() do { if (N_LAUNCHES == 1) xcd_barrier(bar); } while (0)
    const int lo = args.ph_lo, hi = args.ph_hi;
#define IN(k) (lo <= (k) && (k) < hi)
#define SEAM(k) do { if (IN(k) && IN((k) + 1)) GRID_BAR(); } while (0)
    typedef pg8::bf16_t bt;

    if (IN(0)) { p0_prologue(F); } SEAM(0);
    if (IN(1)) { pg8::Gemm g{(const bt*)F.HN, (const bt*)F.W1GU, M, 2 * FF, D, D, D}; pg8::StaticOrder S; S.init(M, 2 * FF, F.G, (int)blockIdx.x);
        pg8::EpiSwiglu E{(bt*)F.HB, FF}; pg8::gemm_phase<pg8::EpiSwiglu, pg8::StaticOrder, true, true>(F.lds + RING_OFF, g, S, E); } SEAM(1);
    if (IN(2)) { pg8::Gemm g{(const bt*)F.HB, (const bt*)F.W1D, M, D, FF, FF, FF}; pg8::StaticOrder S; S.init(M, D, F.G, (int)blockIdx.x);
        pg8::EpiStore E{(bt*)F.FB, D}; pg8::gemm_phase<pg8::EpiStore, pg8::StaticOrder, true, true>(F.lds + RING_OFF, g, S, E); } SEAM(2);
    if (IN(3)) { thin_norm<true>(F, F.FB, F.x, F.out, 0.5f, F.f1_post_g, F.HN, F.mix_pre_g); } SEAM(3);
    if (IN(4)) { pg8::Gemm g{(const bt*)F.HN, (const bt*)F.WIN, M, NIN, D, D, D}; pg8::StaticOrder S; S.init(M, NIN, F.G, (int)blockIdx.x);
        pg8::EpiIn E{(bt*)F.QA, (bt*)F.KV, (bt*)F.QB, (bt*)F.KB, (bt*)F.VB, (bt*)F.RB, (bt*)F.GA, (bt*)F.GB, F.ALR, 0.125f * LOG2E, 0.125f};
        pg8::gemm_phase<pg8::EpiIn, pg8::StaticOrder, true, true>(F.lds + RING_OFF, g, S, E); } SEAM(4);
    if (IN(5)) {
        gla_naive(F);
        __syncthreads();
#if FAST_ATTN
        mix::attn_bias_table(F); __syncthreads();
        for (int u = blockIdx.x; u < BATCH * NKVH * (SEQ / 64); u += F.G) mix::attn_unit(F, u / 64, (u / 32) & 1, u & 31);
#else
        attn_naive(F);
#endif
    } SEAM(5);
    if (IN(6)) { gla_post(F); } SEAM(6);
    if (IN(7)) { pg8::Gemm g{(const bt*)F.HN, (const bt*)F.WPAB, M, D, 512, D, D}; pg8::StaticOrder S; S.init(M, D, F.G, (int)blockIdx.x);
        pg8::EpiGate<false> E{(const bt*)F.GA, (bt*)F.FB}; pg8::gemm_phase<pg8::EpiGate<false>, pg8::StaticOrder, true, true>(F.lds + RING_OFF, g, S, E); } SEAM(7);
    if (IN(8)) { pg8::Gemm g{(const bt*)F.HN + 512, (const bt*)F.WPAB + 512, M, D, 512, D, D}; pg8::StaticOrder S; S.init(M, D, F.G, (int)blockIdx.x);
        pg8::EpiGate<true> E{(const bt*)F.GB, (bt*)F.FB}; pg8::gemm_phase<pg8::EpiGate<true>, pg8::StaticOrder, true, true>(F.lds + RING_OFF, g, S, E); } SEAM(8);
    if (IN(9)) { pg8::Gemm g{(const bt*)F.FB, (const bt*)F.WOUT, M, D, D, D, D}; pg8::StaticOrder S; S.init(M, D, F.G, (int)blockIdx.x);
        pg8::EpiStore E{(bt*)F.MO, D}; pg8::gemm_phase<pg8::EpiStore, pg8::StaticOrder, true, true>(F.lds + RING_OFF, g, S, E); } SEAM(9);
    if (IN(10)) { thin_norm<true>(F, F.MO, F.out, F.out, 1.0f, F.mix_post_g, F.HN, F.f2_pre_g); } SEAM(10);
    if (IN(11)) { pg8::Gemm g{(const bt*)F.HN, (const bt*)F.W2GU, M, 2 * FF, D, D, D}; pg8::StaticOrder S; S.init(M, 2 * FF, F.G, (int)blockIdx.x);
        pg8::EpiSwiglu E{(bt*)F.HB, FF}; pg8::gemm_phase<pg8::EpiSwiglu, pg8::StaticOrder, true, true>(F.lds + RING_OFF, g, S, E); } SEAM(11);
    if (IN(12)) { pg8::Gemm g{(const bt*)F.HB, (const bt*)F.W2D, M, D, FF, FF, FF}; pg8::StaticOrder S; S.init(M, D, F.G, (int)blockIdx.x);
        pg8::EpiStore E{(bt*)F.FB, D}; pg8::gemm_phase<pg8::EpiStore, pg8::StaticOrder, true, true>(F.lds + RING_OFF, g, S, E); } SEAM(12);
    if (IN(13)) { thin_norm<false>(F, F.FB, F.out, F.out, 0.5f, F.f2_post_g, nullptr, nullptr); }
#undef IN
#undef SEAM
#undef GRID_BAR
}

extern "C" void kernel_launch(void* const* d_in, const int* in_sizes, int n_in, void* d_out, int out_size, void* d_ws, size_t ws_size, hipStream_t stream) {
    static int grid = 0;
    if (grid == 0) {
        if (n_in != 22 || in_sizes[0] != M * D || out_size != M * D || ws_size < WS_END || ws_size < WS_BIG + (size_t)M * FF * 2) {
            fprintf(stderr, "kernel_launch: shape/workspace mismatch: n_in %d in0 %d out %d ws %zu (need %zu)\n", n_in, n_in > 0 ? in_sizes[0] : -1, out_size, ws_size, (size_t)WS_END); grid = -1; return; }
        int dev = 0, cus = 0, per_cu = 0;
        if (hipGetDevice(&dev) != hipSuccess || hipDeviceGetAttribute(&cus, hipDeviceAttributeMultiprocessorCount, dev) != hipSuccess) { fprintf(stderr, "kernel_launch: device query failed\n"); grid = -1; return; }
        if (hipFuncSetAttribute((const void*)mk_fwd, hipFuncAttributeMaxDynamicSharedMemorySize, LDS_BYTES) != hipSuccess) { fprintf(stderr, "kernel_launch: hipFuncSetAttribute failed\n"); grid = -1; return; }
        if (hipOccupancyMaxActiveBlocksPerMultiprocessor(&per_cu, (const void*)mk_fwd, NWAVES * 64, LDS_BYTES) != hipSuccess || per_cu < 1)
            fprintf(stderr, "kernel_launch: note: occupancy query reports %d workgroups per CU\n", per_cu);
        (void)hipGetLastError();
        grid = cus;
    }
    if (grid < 0) return;
    if (hipMemsetAsync((char*)d_ws + WS_CTL, 0, CTL_ZERO_BYTES, stream) != hipSuccess) { fprintf(stderr, "kernel_launch: memset failed\n"); return; }
    Args a{};
    for (int i = 0; i < 22; ++i) a.in[i] = (const float*)d_in[i];
    a.out = (float*)d_out; a.ws = (unsigned char*)d_ws;
    for (int li = 0; li < N_LAUNCHES; ++li) {
        a.ph_lo = (N_LAUNCHES == 1) ? 0 : li; a.ph_hi = (N_LAUNCHES == 1) ? N_PHASES : li + 1;
        hipLaunchKernelGGL(mk_fwd, dim3(grid), dim3(NWAVES * 64), LDS_BYTES, stream, a);
        const hipError_t le = hipPeekAtLastError();
        if (le != hipSuccess) { fprintf(stderr, "kernel_launch: launch %d failed: %s\n", li, hipGetErrorName(le)); break; }
    }
}
```

```cpp
#include <hip/hip_runtime.h>
#include <cstdio>
#include <cstdint>
namespace pg8 {
#define PG8_LAS __attribute__((address_space(3)))
typedef unsigned short bf16_t;
typedef short bf16x8 __attribute__((ext_vector_type(8)));
typedef float f32x4 __attribute__((ext_vector_type(4)));
typedef unsigned u32x4 __attribute__((ext_vector_type(4)));
constexpr int BM = 256, BK = 64, HALF = 128, HTB = HALF * BK * 2  , STAGE_BYTES = 8 * HTB, NXCD = 8, WGM = 8;

__host__ __device__ __forceinline__ int lds_byte(int r, int c) { const int st = (r >> 4) * 2 + (c >> 5), rr = r & 15, cc = c & 31, ob = rr * 64 + cc * 2; return st * 1024 + (ob ^ (((ob >> 9) & 1) << 5)); }
__host__ __device__ __forceinline__ void stage_rc(int b, int& R, int& C) { const int st = b / 1024, sb = b % 1024, swz = sb ^ (((sb >> 9) & 1) << 5); R = (st >> 1) * 16 + swz / 64; C = (st & 1) * 32 + (swz % 64) / 2; }
__host__ __device__ __forceinline__ int perm32(int rho) { const int n = rho >> 4, i = rho & 15; return 8 * (i >> 2) + 4 * n + (i & 3); }

struct Unit { int pm, pn; };
struct Gemm { const bf16_t* A; const bf16_t* Bt; int M, N, K, lda, ldb; };

struct StaticOrder {
    int nM, nN, nwg, G, c;
    __host__ __device__ void init(int M, int N, int G_, int c_) { nM = M / BM; nN = N / BM; nwg = nM * nN; G = G_; c = c_; }
    __host__ __device__ bool next(int i, Unit& u) const {
        const long L = (long)i * G + c; if (L >= nwg) return false;
        int wgid = (int)L; { const int q = nwg / NXCD, r = nwg % NXCD, xcd = wgid % NXCD, off = wgid / NXCD; wgid = (xcd < r ? xcd * (q + 1) : r * (q + 1) + (xcd - r) * q) + off; }
        const int nig = WGM * nN, gid = wgid / nig, fm = gid * WGM, gsz = (nM - fm) < WGM ? (nM - fm) : WGM;
        u.pm = fm + ((wgid % nig) % gsz); u.pn = (wgid % nig) / gsz; return true;
    }
    __device__ __forceinline__ void a_ready(const Unit&) const {}
    __device__ __forceinline__ void done(const Unit&) const {}
};

__device__ __forceinline__ unsigned cvt_pk_bf16(float lo, float hi) { unsigned r; asm volatile("v_cvt_pk_bf16_f32 %0, %1, %2" : "=v"(r) : "v"(lo), "v"(hi)); return r; }
typedef float f32x2 __attribute__((ext_vector_type(2)));

__device__ __forceinline__ float bf_lo(unsigned w) { return __uint_as_float(w << 16); }
__device__ __forceinline__ float bf_hi(unsigned w) { return __uint_as_float(w & 0xffff0000u); }
__device__ __forceinline__ float sigmoid_f(float v) { return __builtin_amdgcn_rcpf(1.0f + __builtin_amdgcn_exp2f(v * -1.4426950408889634f)); }
__device__ __forceinline__ u32x4 pack8(const f32x4 v0, const f32x4 v1) { u32x4 w; w.x = cvt_pk_bf16(v0[0], v0[1]); w.y = cvt_pk_bf16(v0[2], v0[3]); w.z = cvt_pk_bf16(v1[0], v1[1]); w.w = cvt_pk_bf16(v1[2], v1[3]); return w; }

struct EpiStore {
    static constexpr bool PERM = true, AFTER_DRAIN = false;
    bf16_t* O; int ldc;
    __device__ __forceinline__ void operator()(const f32x4 (&acc)[2][2][4][2], const Unit& u, int wr, int wc, int fr, int fq) const {
        const int row0 = u.pm * BM + wr * 64 + fr; const int col0 = u.pn * BM + wc * 32 + 8 * fq;
#pragma unroll
        for (int ai = 0; ai < 2; ++ai)
#pragma unroll
            for (int m = 0; m < 4; ++m) { bf16_t* rowp = O + (size_t)(row0 + ai * HALF + m * 16) * ldc + col0;
#pragma unroll
                for (int bj = 0; bj < 2; ++bj) *(u32x4*)(rowp + bj * HALF) = pack8(acc[ai][bj][m][0], acc[ai][bj][m][1]); }
    }
};
struct EpiSwiglu {
    static constexpr bool PERM = true, AFTER_DRAIN = false;
    bf16_t* O; int ldc;
    __device__ __forceinline__ void operator()(const f32x4 (&acc)[2][2][4][2], const Unit& u, int wr, int wc, int fr, int fq) const {
        const int row0 = u.pm * BM + wr * 64 + fr; const int col0 = u.pn * HALF + wc * 32 + 8 * fq;
#pragma unroll
        for (int ai = 0; ai < 2; ++ai)
#pragma unroll
            for (int m = 0; m < 4; ++m) { bf16_t* rowp = O + (size_t)(row0 + ai * HALF + m * 16) * ldc + col0;
                f32x4 h[2];
#pragma unroll
                for (int n = 0; n < 2; ++n)
#pragma unroll
                    for (int i = 0; i < 4; ++i) { const float g = acc[ai][0][m][n][i], up = acc[ai][1][m][n][i]; h[n][i] = g * sigmoid_f(g) * up; }
                *(u32x4*)rowp = pack8(h[0], h[1]); }
    }
};
struct EpiIn {
    static constexpr bool PERM = true, AFTER_DRAIN = false;
    bf16_t *QA, *KV, *QB, *KB, *VB, *RB, *GA, *GB; float* ALR; float qa_scale, qb_scale;
    __device__ __forceinline__ void operator()(const f32x4 (&acc)[2][2][4][2], const Unit& u, int wr, int wc, int fr, int fq) const {
        const int pn = u.pn; const int row0 = u.pm * BM + wr * 64 + fr;
        if (pn == 17) {
            if (wc == 0 && fq < 2) {
#pragma unroll
                for (int ai = 0; ai < 2; ++ai)
#pragma unroll
                    for (int m = 0; m < 4; ++m) { float* p = ALR + (size_t)(row0 + ai * HALF + m * 16) * 16 + 8 * fq;
                        *(f32x4*)p = acc[ai][0][m][0]; *(f32x4*)(p + 4) = acc[ai][0][m][1]; }
            }
            return;
        }
        bf16_t* base; int ld, colt; float sc = 1.f; int act = 0;
        if (pn < 2) { base = QA; ld = 512; colt = pn * 256; sc = qa_scale; }
        else if (pn == 2) { base = KV; ld = 256; colt = 0; }
        else if (pn == 3) { base = QB; ld = 256; colt = 0; sc = qb_scale; }
        else if (pn == 4) { base = KB; ld = 256; colt = 0; }
        else if (pn < 7) { base = VB; ld = 512; colt = (pn - 5) * 256; }
        else if (pn < 9) { base = RB; ld = 512; colt = (pn - 7) * 256; act = 2; }
        else if (pn < 13) { base = GA; ld = 1024; colt = (pn - 9) * 256; act = 1; }
        else { base = GB; ld = 1024; colt = (pn - 13) * 256; act = 1; }
        const int col0 = colt + wc * 32 + 8 * fq;
#pragma unroll
        for (int ai = 0; ai < 2; ++ai)
#pragma unroll
            for (int m = 0; m < 4; ++m) { bf16_t* rowp = base + (size_t)(row0 + ai * HALF + m * 16) * ld + col0;
#pragma unroll
                for (int bj = 0; bj < 2; ++bj) { f32x4 v0 = acc[ai][bj][m][0] * sc, v1 = acc[ai][bj][m][1] * sc;
                    if (act != 0) {
#pragma unroll
                        for (int i = 0; i < 4; ++i) { const float s0 = sigmoid_f(v0[i]), s1 = sigmoid_f(v1[i]); v0[i] = (act == 1) ? s0 : v0[i] * s0; v1[i] = (act == 1) ? s1 : v1[i] * s1; }
                    }
                    *(u32x4*)(rowp + bj * HALF) = pack8(v0, v1); } }
    }
};
template <bool SECOND> struct EpiGate {
    static constexpr bool PERM = true, AFTER_DRAIN = false;
    const bf16_t* Gt; bf16_t* O;
    __device__ __forceinline__ void operator()(const f32x4 (&acc)[2][2][4][2], const Unit& u, int wr, int wc, int fr, int fq) const {
        const int row0 = u.pm * BM + wr * 64 + fr; const int col0 = u.pn * BM + wc * 32 + 8 * fq;
#pragma unroll
        for (int ai = 0; ai < 2; ++ai)
#pragma unroll
            for (int m = 0; m < 4; ++m) { const size_t off = (size_t)(row0 + ai * HALF + m * 16) * 1024 + col0;
#pragma unroll
                for (int bj = 0; bj < 2; ++bj) { const u32x4 gw = *(const u32x4*)(Gt + off + bj * HALF);
                    f32x4 v0 = acc[ai][bj][m][0], v1 = acc[ai][bj][m][1];
                    v0[0] *= bf_lo(gw.x); v0[1] *= bf_hi(gw.x); v0[2] *= bf_lo(gw.y); v0[3] *= bf_hi(gw.y);
                    v1[0] *= bf_lo(gw.z); v1[1] *= bf_hi(gw.z); v1[2] *= bf_lo(gw.w); v1[3] *= bf_hi(gw.w);
                    if (SECOND) { const u32x4 pw = *(const u32x4*)(O + off + bj * HALF);
                        v0[0] += bf_lo(pw.x); v0[1] += bf_hi(pw.x); v0[2] += bf_lo(pw.y); v0[3] += bf_hi(pw.y);
                        v1[0] += bf_lo(pw.z); v1[1] += bf_hi(pw.z); v1[2] += bf_lo(pw.w); v1[3] += bf_hi(pw.w); }
                    *(u32x4*)(O + off + bj * HALF) = pack8(v0, v1); } }
    }
};
template <class Epi, class Sched, bool ALIGN_EPI = false, bool SP2 = false>
__device__ __forceinline__ void gemm_phase(PG8_LAS unsigned char* lds, const Gemm g, const Sched& S, const Epi& E) {
    const int tid = threadIdx.x, wid = __builtin_amdgcn_readfirstlane(tid >> 6), lane = tid & 63, wr = wid >> 2, wc = wid & 3, fr = lane & 15, fq = lane >> 4;
    const int K = g.K, nt = K / BK;
    unsigned voffA[2], voffB[2];
#pragma unroll
    for (int i = 0; i < 2; ++i) { int R, C; stage_rc(tid * 16 + i * 8192, R, C); const int Rb = Epi::PERM ? ((R & ~31) + perm32(R & 31)) : R;
        voffA[i] = (unsigned)(R * g.lda + C) * 2u; voffB[i] = (unsigned)(Rb * g.ldb + C) * 2u; }
    const size_t kstep = (size_t)(BK * 2);
    const size_t hsA = (size_t)HALF * g.lda * 2, hsB = (size_t)HALF * g.ldb * 2;
    const size_t tsA = 2 * hsA, tsB = 2 * hsB;
    const unsigned ldsw = (unsigned)wid * 1024u;
    const int aoff = lds_byte(wr * 64 + fr, fq * 8), boff = lds_byte(wc * 32 + fr, fq * 8);
#define PG8_SA(b, h) (((b) * 2 + (h)) * HTB)
#define PG8_SB(b, h) ((4 + (b) * 2 + (h)) * HTB)
#define PG8_STAGE(bufoff, gbase, voff) do { _Pragma("unroll") for (int _i = 0; _i < 2; ++_i) \
        __builtin_amdgcn_global_load_lds((const unsigned*)((const char*)(gbase) + (voff)[_i]), (PG8_LAS unsigned*)(lds + (bufoff) + ldsw + _i * 8192), 16, 0, 0); } while (0)
#define PG8_LDA(dst, b, h) do { _Pragma("unroll") for (int m = 0; m < 4; ++m) _Pragma("unroll") for (int k = 0; k < 2; ++k) dst[m][k] = *(const PG8_LAS bf16x8*)(lds + PG8_SA(b, h) + aoff + m * 2048 + k * 1024); } while (0)
#define PG8_LDB(dst, b, h) do { _Pragma("unroll") for (int n = 0; n < 2; ++n) _Pragma("unroll") for (int k = 0; k < 2; ++k) dst[n][k] = *(const PG8_LAS bf16x8*)(lds + PG8_SB(b, h) + boff + n * 2048 + k * 1024); } while (0)
#define PG8_MMA(ai, bj, At, Bt) do { __builtin_amdgcn_s_setprio(1); _Pragma("unroll") for (int m = 0; m < 4; ++m) _Pragma("unroll") for (int n = 0; n < 2; ++n) _Pragma("unroll") for (int k = 0; k < 2; ++k) \
        acc[ai][bj][m][n] = __builtin_amdgcn_mfma_f32_16x16x32_bf16(Bt[n][k], At[m][k], acc[ai][bj][m][n], 0, 0, 0); __builtin_amdgcn_s_setprio(0); } while (0)
#define PG8_WAIT_V(n) asm volatile("s_waitcnt vmcnt(" #n ")" ::: "memory")
#define PG8_WAIT_L(n) asm volatile("s_waitcnt lgkmcnt(" #n ")" ::: "memory")
#define PG8_BAR __builtin_amdgcn_s_barrier()
#define PG8_SCHED __builtin_amdgcn_sched_barrier(0)
    Unit cur, nxt; int ui = 0;
    if (!S.next(0, cur)) return;
    f32x4 acc[2][2][4][2];
#pragma unroll
    for (int a = 0; a < 2; ++a)
#pragma unroll
        for (int b = 0; b < 2; ++b)
#pragma unroll
            for (int m = 0; m < 4; ++m)
#pragma unroll
                for (int n = 0; n < 2; ++n) acc[a][b][m][n] = (f32x4){0.f, 0.f, 0.f, 0.f};
    bf16x8 At[4][2], B0[2][2], B1[2][2];
    const char* cA = (const char*)g.A + (size_t)cur.pm * tsA; const char* cB = (const char*)g.Bt + (size_t)cur.pn * tsB;
    S.a_ready(cur);
    if constexpr (SP2) {
        PG8_STAGE(PG8_SB(0, 0), cB, voffB); PG8_STAGE(PG8_SB(0, 1), cB + hsB, voffB); PG8_STAGE(PG8_SA(0, 0), cA, voffA); PG8_STAGE(PG8_SA(0, 1), cA + hsA, voffA);
        if (wr == 1) PG8_BAR;
        PG8_WAIT_V(2); PG8_BAR;
        PG8_STAGE(PG8_SB(1, 0), cB + kstep, voffB); PG8_STAGE(PG8_SA(1, 0), cA + kstep, voffA); PG8_STAGE(PG8_SB(1, 1), cB + hsB + kstep, voffB);
        PG8_WAIT_V(6); PG8_BAR;
    } else {
        PG8_STAGE(PG8_SB(0, 0), cB, voffB); PG8_STAGE(PG8_SA(0, 0), cA, voffA); PG8_STAGE(PG8_SB(0, 1), cB + hsB, voffB); PG8_STAGE(PG8_SA(0, 1), cA + hsA, voffA);
        if (wr == 1) PG8_BAR;
        PG8_WAIT_V(4); PG8_BAR;
        PG8_STAGE(PG8_SB(1, 0), cB + kstep, voffB); PG8_STAGE(PG8_SA(1, 0), cA + kstep, voffA); PG8_STAGE(PG8_SB(1, 1), cB + hsB + kstep, voffB);
        PG8_WAIT_V(6); PG8_BAR;
    }
    for (;;) {
        const bool has_next = S.next(ui + 1, nxt);
        const char* nA = has_next ? (const char*)g.A + (size_t)nxt.pm * tsA : cA; const char* nB = has_next ? (const char*)g.Bt + (size_t)nxt.pn * tsB : cB;
        for (int t = 0; t < nt; t += 2) {
            const bool last = (t == nt - 2);
            const char* a1 = cA + (size_t)(t + 1) * kstep;
            const char* a2 = last ? nA : cA + (size_t)(t + 2) * kstep; const char* b2 = last ? nB : cB + (size_t)(t + 2) * kstep;
            const char* a3 = a2 + kstep; const char* b3 = b2 + kstep;
            if (last && has_next) S.a_ready(nxt);
            if constexpr (SP2) {
            PG8_LDB(B0, 0, 0); PG8_LDB(B1, 0, 1); PG8_SCHED; PG8_LDA(At, 0, 0); PG8_STAGE(PG8_SA(1, 1), a1 + hsA, voffA);
            PG8_WAIT_V(8); PG8_WAIT_L(0); PG8_BAR; PG8_MMA(0, 0, At, B0); PG8_MMA(0, 1, At, B1); PG8_BAR; PG8_SCHED;
            PG8_LDA(At, 0, 1); PG8_STAGE(PG8_SB(0, 0), b2, voffB); PG8_STAGE(PG8_SB(0, 1), b2 + hsB, voffB); PG8_STAGE(PG8_SA(0, 0), a2, voffA);
            PG8_WAIT_V(8); PG8_WAIT_L(0); PG8_BAR; PG8_MMA(1, 0, At, B0); PG8_MMA(1, 1, At, B1); PG8_BAR; PG8_SCHED;
            PG8_LDB(B0, 1, 0); PG8_LDB(B1, 1, 1); PG8_SCHED; PG8_LDA(At, 1, 0); PG8_STAGE(PG8_SA(0, 1), a2 + hsA, voffA);
            PG8_WAIT_V(8); PG8_WAIT_L(0); PG8_BAR; PG8_MMA(0, 0, At, B0); PG8_MMA(0, 1, At, B1); PG8_BAR; PG8_SCHED;
            PG8_LDA(At, 1, 1); PG8_STAGE(PG8_SB(1, 0), b3, voffB); PG8_STAGE(PG8_SB(1, 1), b3 + hsB, voffB); PG8_STAGE(PG8_SA(1, 0), a3, voffA);
            PG8_WAIT_V(8); PG8_WAIT_L(0); PG8_BAR; PG8_MMA(1, 0, At, B0); PG8_MMA(1, 1, At, B1); PG8_BAR; PG8_SCHED;
            } else {
            PG8_LDB(B0, 0, 0); PG8_SCHED; PG8_LDA(At, 0, 0); PG8_STAGE(PG8_SA(1, 1), a1 + hsA, voffA);
            PG8_WAIT_L(8); PG8_BAR; PG8_WAIT_L(0); PG8_MMA(0, 0, At, B0); PG8_BAR; PG8_SCHED;
            PG8_LDB(B1, 0, 1); PG8_STAGE(PG8_SB(0, 0), b2, voffB);
            PG8_BAR; PG8_WAIT_L(0); PG8_MMA(0, 1, At, B1); PG8_BAR;
            PG8_LDA(At, 0, 1); PG8_STAGE(PG8_SA(0, 0), a2, voffA);
            PG8_BAR; PG8_WAIT_L(0); PG8_MMA(1, 0, At, B0); PG8_BAR; PG8_SCHED;
            PG8_STAGE(PG8_SB(0, 1), b2 + hsB, voffB);
            PG8_WAIT_V(6); PG8_BAR; PG8_MMA(1, 1, At, B1); PG8_BAR;
            PG8_LDB(B0, 1, 0); PG8_SCHED; PG8_LDA(At, 1, 0); PG8_STAGE(PG8_SA(0, 1), a2 + hsA, voffA);
            PG8_WAIT_L(8); PG8_BAR; PG8_WAIT_L(0); PG8_MMA(0, 0, At, B0); PG8_BAR; PG8_SCHED;
            PG8_LDB(B1, 1, 1); PG8_STAGE(PG8_SB(1, 0), b3, voffB);
            PG8_BAR; PG8_WAIT_L(0); PG8_MMA(0, 1, At, B1); PG8_BAR;
            PG8_LDA(At, 1, 1); PG8_STAGE(PG8_SA(1, 0), a3, voffA);
            PG8_BAR; PG8_WAIT_L(0); PG8_MMA(1, 0, At, B0); PG8_BAR; PG8_SCHED;
            PG8_STAGE(PG8_SB(1, 1), b3 + hsB, voffB);
            PG8_WAIT_V(6); PG8_BAR; PG8_MMA(1, 1, At, B1); PG8_BAR;
            }
        }
        if constexpr (ALIGN_EPI) { if (wr == 0) PG8_BAR; }
        if constexpr (!Epi::AFTER_DRAIN) { E(acc, cur, wr, wc, fr, fq); S.done(cur); }
        if (!has_next) break;
#pragma unroll
        for (int a = 0; a < 2; ++a)
#pragma unroll
            for (int b = 0; b < 2; ++b)
#pragma unroll
                for (int m = 0; m < 4; ++m)
#pragma unroll
                    for (int n = 0; n < 2; ++n) acc[a][b][m][n] = (f32x4){0.f, 0.f, 0.f, 0.f};
        cur = nxt; cA = nA; cB = nB; ++ui;
        if constexpr (ALIGN_EPI) { if (wr == 1) PG8_BAR; }
    }
    PG8_WAIT_V(0);
    if constexpr (!ALIGN_EPI) { if (wr == 0) PG8_BAR; }
    PG8_BAR;
    if constexpr (Epi::AFTER_DRAIN) { E.fused(acc, cur, wr, wc, fr, fq, lds, wid, lane); S.done(cur); }
#undef PG8_SA
#undef PG8_SB
#undef PG8_STAGE
#undef PG8_LDA
#undef PG8_LDB
#undef PG8_MMA
#undef PG8_WAIT_V
#undef PG8_WAIT_L
#undef PG8_BAR
#undef PG8_SCHED
}
}

#ifndef FAST_GLA
#define FAST_GLA 1
#endif
constexpr int NWAVES = 8;
#ifndef MK_N_LAUNCHES
#define MK_N_LAUNCHES 1
#endif
constexpr int N_PHASES = 14;
constexpr int N_LAUNCHES = MK_N_LAUNCHES;
static_assert(N_LAUNCHES == 1 || N_LAUNCHES == N_PHASES, "MK_N_LAUNCHES is 1 or N_PHASES");

constexpr int BATCH = 16, SEQ = 2048, D = 1024, FF = 2816;
constexpr int M = BATCH * SEQ;
constexpr int NQH = 8, NKVH = 2, HD = 64, WINDOW = 128;
constexpr int GH = 4, GDK = 64, GDV = 128, GRANK = 16;
constexpr int IN_W = 4368, NIN = 4608;
constexpr float EPS = 1e-6f;
constexpr float LOG2E = 1.4426950408889634f;

constexpr size_t MiB = 1u << 20;
constexpr size_t WS_CTL = 0, CTL_ZERO_BYTES = 1 * MiB;
constexpr size_t WS_W1GU = 2 * MiB, WS_W1D = 13 * MiB, WS_W2GU = 19 * MiB, WS_W2D = 30 * MiB, WS_WIN = 36 * MiB, WS_WPAB = 45 * MiB, WS_WOUT = 47 * MiB;
constexpr size_t WS_HN = 64 * MiB;
constexpr size_t WS_F = 128 * MiB;
constexpr size_t WS_BIG = 192 * MiB;
constexpr size_t WS_QA = WS_BIG, WS_KV = WS_QA + 32 * MiB, WS_QB = WS_KV + 16 * MiB, WS_KB = WS_QB + 16 * MiB, WS_VB = WS_KB + 16 * MiB, WS_RB = WS_VB + 32 * MiB,
                 WS_GA = WS_RB + 32 * MiB, WS_GB = WS_GA + 64 * MiB, WS_ALR = WS_GB + 64 * MiB, WS_END = WS_ALR + 2 * MiB;
constexpr size_t WS_MO = WS_BIG;
static_assert(WS_W1GU + (size_t)2 * FF * D * 2 <= WS_W1D && WS_W1D + (size_t)D * FF * 2 <= WS_W2GU && WS_W2GU + (size_t)2 * FF * D * 2 <= WS_W2D && WS_W2D + (size_t)D * FF * 2 <= WS_WIN &&
              WS_WIN + (size_t)NIN * D * 2 <= WS_WPAB && WS_WPAB + (size_t)D * D * 2 <= WS_WOUT && WS_WOUT + (size_t)D * D * 2 <= WS_HN, "weight map");
static_assert(WS_BIG + (size_t)M * FF * 2 <= 512 * MiB && WS_END <= 512 * MiB, "d_ws map");
constexpr int CW_TMO = 0, CW_CODE = 1;
constexpr int CW_BAR = 4096;

constexpr int RING_OFF = 0, RING_BYTES = 131072;
constexpr int LDSCTL_OFF = RING_BYTES, MISC_OFF = LDSCTL_OFF + 320;
constexpr int LDS_BYTES = 147456;
static_assert(MISC_OFF + 128 <= LDS_BYTES, "LDS map");
#define GAS __attribute__((address_space(1)))
#define LAS __attribute__((address_space(3)))
typedef unsigned short bf16;
typedef unsigned v4u __attribute__((ext_vector_type(4)));
typedef float f32x4 __attribute__((ext_vector_type(4)));
typedef short bf16x8 __attribute__((ext_vector_type(8)));
typedef GAS unsigned gu32;
typedef GAS unsigned long long gu64;
#define RLX_AGENT __ATOMIC_RELAXED, __HIP_MEMORY_SCOPE_AGENT
#define LDS_WAIT() asm volatile("s_waitcnt lgkmcnt(0)" ::: "memory")
#define VM_WAIT() asm volatile("s_waitcnt vmcnt(0)" ::: "memory")
__device__ __forceinline__ unsigned long long rt() { return __builtin_amdgcn_s_memrealtime(); }
__device__ __forceinline__ unsigned f2bf(float f) { unsigned u = __builtin_bit_cast(unsigned, f); return (u + 0x7fffu + ((u >> 16) & 1u)) >> 16; }
__device__ __forceinline__ unsigned pk2(float lo, float hi) { return f2bf(lo) | (f2bf(hi) << 16); }
#define XB_TMO      128
#define XB_XCNT(j)  (256  + 64 * (j))
#define XB_XSUB(j)  (1280 + 64 * (j))
#define XB_XGEN(j)  (2304 + 64 * (j))
#define XB_TOP      3328
#define XB_TOPGEN   3392
#define XCD_BAR_WORDS 3456
#define XB_SPIN_CAP (1u << 18)

__device__ __forceinline__ unsigned xb_ld(unsigned* p)              { return __hip_atomic_load(p, __ATOMIC_RELAXED, __HIP_MEMORY_SCOPE_AGENT); }
__device__ __forceinline__ unsigned xb_add(unsigned* p, unsigned v) { return __hip_atomic_fetch_add(p, v, __ATOMIC_RELAXED, __HIP_MEMORY_SCOPE_AGENT); }
__device__ __forceinline__ unsigned xb_xcc_id() { return (unsigned)__builtin_amdgcn_s_getreg((3 << 11) | 20) & 0xFu; }
#define XB_SPIN(cond, bar) do { unsigned _sp = 0; while (cond) { __builtin_amdgcn_s_sleep(1); \
    if ((++_sp & 255u) == 0u) { if (xb_ld(&(bar)[XB_TMO])) break; if (_sp > XB_SPIN_CAP) { atomicAdd(&(bar)[XB_TMO], 1u); break; } } } } while (0)

struct XcdBarrier {
    unsigned* bar; unsigned x;
    volatile LAS unsigned* st;
};

__device__ __forceinline__ XcdBarrier xcd_barrier_post(unsigned* bar, volatile LAS unsigned* st) {
    XcdBarrier b; b.bar = bar; b.x = xb_xcc_id(); b.st = st;
    if (threadIdx.x == 0) (void)xb_add(&bar[XB_XCNT(b.x)], 1u);
    return b;
}
__device__ __forceinline__ void xcd_barrier_complete(unsigned* bar, unsigned x, unsigned& nloc, unsigned& nx) {
    const unsigned G = gridDim.x * gridDim.y * gridDim.z;
    unsigned sum, cnt, mine, sp = 0u;
    for (;;) {
        sum = 0u; cnt = 0u; mine = 0u;
#pragma unroll
        for (unsigned j = 0; j < 16; ++j) { const unsigned c = xb_ld(&bar[XB_XCNT(j)]); sum += c; cnt += (c > 0u) ? 1u : 0u; mine = (j == x) ? c : mine; }
        if (sum == G) break;
        __builtin_amdgcn_s_sleep(1);
        if ((++sp & 255u) == 0u) { if (xb_ld(&bar[XB_TMO])) break; if (sp > XB_SPIN_CAP) { atomicAdd(&bar[XB_TMO], 1u); break; } }
    }
    nloc = mine > 0u ? mine : 1u; nx = cnt > 0u ? cnt : 1u;
}

__device__ __forceinline__ void xcd_barrier(const XcdBarrier& b) {
    asm volatile("s_waitcnt vmcnt(0)" ::: "memory");
    __syncthreads();
    if (threadIdx.x == 0) {
        unsigned* bar = b.bar;
        __builtin_amdgcn_s_waitcnt(0);
        unsigned nloc = b.st[0], nx = b.st[1];
        if (nloc == 0u) { xcd_barrier_complete(bar, b.x, nloc, nx); b.st[0] = nloc; b.st[1] = nx; }
        const unsigned old = xb_add(&bar[XB_XSUB(b.x)], 1u);
        const unsigned gen = old / nloc;
        if (old + 1u == (gen + 1u) * nloc) {
            __builtin_amdgcn_fence(__ATOMIC_RELEASE, "agent");
            asm volatile("s_waitcnt vmcnt(0)" ::: "memory");
            const unsigned og = xb_add(&bar[XB_TOP], 1u);
            const unsigned tg = og / nx;
            if (og + 1u == (tg + 1u) * nx) xb_add(&bar[XB_TOPGEN], 1u);
            else XB_SPIN(xb_ld(&bar[XB_TOPGEN]) == tg, bar);
            __builtin_amdgcn_fence(__ATOMIC_ACQUIRE, "agent");
            xb_add(&bar[XB_XGEN(b.x)], 1u);
            asm volatile("s_waitcnt vmcnt(0)" ::: "memory");
        } else {
            XB_SPIN(xb_ld(&bar[XB_XGEN(b.x)]) == gen, bar);
            __builtin_amdgcn_fence(__ATOMIC_ACQUIRE, "agent");
            asm volatile("s_waitcnt vmcnt(0)" ::: "memory");
        }
    }
    __syncthreads();
}

struct Frame {
    LAS unsigned char* lds;
    volatile LAS unsigned* MISC;
    gu32* ctl;
    int tid, lane, wave;
    int vcu, G;
    const float* x; float* out;
    const float *rel_bias, *f1_pre_g, *f1_wg, *f1_wu, *f1_wd, *f1_post_g, *mix_pre_g, *w_in, *w_alpha, *b_alpha, *sinks, *gla_g, *w_pa, *w_pb, *w_out, *mix_post_g,
                *f2_pre_g, *f2_wg, *f2_wu, *f2_wd, *f2_post_g;
    bf16 *W1GU, *W1D, *W2GU, *W2D, *WIN, *WPAB, *WOUT;
    bf16 *HN, *FB, *HB, *QA, *KV, *QB, *KB, *VB, *RB, *GA, *GB, *MO;
    float *ALR, *OG;
};

__device__ __forceinline__ float wave_sum(float v) {
#pragma unroll
    for (int o = 1; o < 64; o <<= 1) v += __shfl_xor(v, o);
    return v;
}
__device__ __forceinline__ void p0_transpose_item(const float* W, int ldw, int k0, int n0, int nvalid, bf16* WT, int ldt, int drow0, int kd0, LAS float* scr, int lane) {
#pragma unroll 8
    for (int i = 0; i < 32; ++i) { const int kk = 2 * i + (lane >> 5); const int nn = lane & 31; scr[kk * 33 + nn] = (nn < nvalid) ? W[(size_t)(k0 + kk) * ldw + n0 + nn] : 0.f; }
    LDS_WAIT(); asm volatile("" ::: "memory");
    const int c = lane & 7;
#pragma unroll
    for (int j = 0; j < 4; ++j) { const int n = (lane >> 3) + 8 * j; const LAS float* s = scr + (8 * c) * 33 + n;
        v4u o; o.x = pk2(s[0 * 33], s[1 * 33]); o.y = pk2(s[2 * 33], s[3 * 33]); o.z = pk2(s[4 * 33], s[5 * 33]); o.w = pk2(s[6 * 33], s[7 * 33]);
        *(GAS v4u*)(WT + (size_t)(drow0 + n) * ldt + kd0 + 8 * c) = o; }
    LDS_WAIT(); asm volatile("" ::: "memory");
}
__device__ __forceinline__ void p0_item_gu(const float* Wg, const float* Wu, bf16* WT, int r, LAS float* scr, int lane) {
    constexpr int NB = FF / 32;
    const int which = r / (16 * NB); r -= which * 16 * NB; const int kb = r / NB, nb = r % NB, n0 = 32 * nb;
    const int drow = 256 * (n0 / 128) + (n0 % 128) + which * 128;
    p0_transpose_item(which ? Wu : Wg, FF, 64 * kb, n0, 32, WT, D, drow, 64 * kb, scr, lane);
}
__device__ __forceinline__ void p0_item_down(const float* Wd, bf16* WT, int r, LAS float* scr, int lane) {
    const int kb = r / 32, nb = r % 32;
    p0_transpose_item(Wd, D, 64 * kb, 32 * nb, 32, WT, FF, 32 * nb, 64 * kb, scr, lane);
}
__device__ __forceinline__ void p0_prologue(Frame& F) {
    LAS float* scr = (LAS float*)(F.lds + RING_OFF + F.wave * 16384);
    const int gw = F.vcu * NWAVES + F.wave, NGW = F.G * NWAVES;
    constexpr int I_GU = 2 * 16 * (FF / 32), I_DN = (FF / 64) * (D / 32), I_IN = 16 * 137, I_P = 8 * 32, I_O = 16 * 32;
    constexpr int NITEMS = 2 * I_GU + 2 * I_DN + I_IN + 2 * I_P + I_O;
    for (int it = gw; it < NITEMS; it += NGW) {
        int r = it;
        if (r < I_GU) { p0_item_gu(F.f1_wg, F.f1_wu, F.W1GU, r, scr, F.lane); continue; } r -= I_GU;
        if (r < I_GU) { p0_item_gu(F.f2_wg, F.f2_wu, F.W2GU, r, scr, F.lane); continue; } r -= I_GU;
        if (r < I_DN) { p0_item_down(F.f1_wd, F.W1D, r, scr, F.lane); continue; } r -= I_DN;
        if (r < I_DN) { p0_item_down(F.f2_wd, F.W2D, r, scr, F.lane); continue; } r -= I_DN;
        if (r < I_IN) {
            const int kb = r / 137, nb = r % 137;
            if (nb < 136) { const int drow = 32 * nb; const int scol = drow < 2304 ? drow : drow + 16; p0_transpose_item(F.w_in, IN_W, 64 * kb, scol, 32, F.WIN, D, drow, 64 * kb, scr, F.lane); }
            else p0_transpose_item(F.w_in, IN_W, 64 * kb, 2304, 16, F.WIN, D, 4352, 64 * kb, scr, F.lane);
            continue; } r -= I_IN;
        if (r < I_P) { const int kb = r / 32, nb = r % 32; p0_transpose_item(F.w_pa, D, 64 * kb, 32 * nb, 32, F.WPAB, D, 32 * nb, 64 * kb, scr, F.lane); continue; } r -= I_P;
        if (r < I_P) { const int kb = r / 32, nb = r % 32; p0_transpose_item(F.w_pb, D, 64 * kb, 32 * nb, 32, F.WPAB, D, 32 * nb, 512 + 64 * kb, scr, F.lane); continue; } r -= I_P;
        { const int kb = r / 32, nb = r % 32; p0_transpose_item(F.w_out, D, 64 * kb, 32 * nb, 32, F.WOUT, D, 32 * nb, 64 * kb, scr, F.lane); }
    }
    for (int rr = gw; rr < 224; rr += NGW) { GAS v4u* o = (GAS v4u*)(F.WIN + (size_t)(4384 + rr) * D) + F.lane; o[0] = (v4u){0u, 0u, 0u, 0u}; o[64] = (v4u){0u, 0u, 0u, 0u}; }
    {
        f32x4 g[4];
#pragma unroll
        for (int j = 0; j < 4; ++j) g[j] = ((const GAS f32x4*)F.f1_pre_g)[F.lane + 64 * j];
        for (int m = gw; m < M; m += NGW) {
            const GAS f32x4* xr = (const GAS f32x4*)(F.x + (size_t)m * D) + F.lane;
            f32x4 v[4]; float s = 0.f;
#pragma unroll
            for (int j = 0; j < 4; ++j) { v[j] = xr[64 * j]; s += (v[j].x * v[j].x + v[j].y * v[j].y) + (v[j].z * v[j].z + v[j].w * v[j].w); }
            const float rs = 1.f / sqrtf(wave_sum(s) * (1.f / D) + EPS);
            GAS unsigned long long* o8 = (GAS unsigned long long*)(F.HN + (size_t)m * D) + F.lane;
#pragma unroll
            for (int j = 0; j < 4; ++j) { const f32x4 y = v[j] * rs * g[j]; o8[64 * j] = (unsigned long long)pk2(y.x, y.y) | ((unsigned long long)pk2(y.z, y.w) << 32); }
        }
    }
}
template <bool HAS_HN> __device__ __forceinline__ void thin_norm(Frame& F, const bf16* fin, const float* xi, float* xo, float coef, const float* gpost, bf16* hn, const float* gpre) {
    const int gw = F.vcu * NWAVES + F.wave, NGW = F.G * NWAVES;
    f32x4 gp[4], gq[4];
#pragma unroll
    for (int j = 0; j < 4; ++j) { gp[j] = ((const GAS f32x4*)gpost)[F.lane + 64 * j] * coef; if (HAS_HN) gq[j] = ((const GAS f32x4*)gpre)[F.lane + 64 * j]; }
    for (int m = gw; m < M; m += NGW) {
        const GAS unsigned long long* fr = (const GAS unsigned long long*)(fin + (size_t)m * D) + F.lane;
        const GAS f32x4* xr = (const GAS f32x4*)(xi + (size_t)m * D) + F.lane;
        f32x4 f[4], xv[4]; float s = 0.f;
#pragma unroll
        for (int j = 0; j < 4; ++j) { const unsigned long long w = fr[64 * j]; const unsigned lo = (unsigned)w, hi = (unsigned)(w >> 32);
            f[j] = (f32x4){pg8::bf_lo(lo), pg8::bf_hi(lo), pg8::bf_lo(hi), pg8::bf_hi(hi)}; xv[j] = xr[64 * j];
            s += (f[j].x * f[j].x + f[j].y * f[j].y) + (f[j].z * f[j].z + f[j].w * f[j].w); }
        const float rs = 1.f / sqrtf(wave_sum(s) * (1.f / D) + EPS);
        float s2 = 0.f;
        GAS f32x4* xw = (GAS f32x4*)(xo + (size_t)m * D) + F.lane;
#pragma unroll
        for (int j = 0; j < 4; ++j) { xv[j] = xv[j] + f[j] * rs * gp[j]; xw[64 * j] = xv[j]; s2 += (xv[j].x * xv[j].x + xv[j].y * xv[j].y) + (xv[j].z * xv[j].z + xv[j].w * xv[j].w); }
        if (HAS_HN) {
            const float rs2 = 1.f / sqrtf(wave_sum(s2) * (1.f / D) + EPS);
            GAS unsigned long long* o8 = (GAS unsigned long long*)(hn + (size_t)m * D) + F.lane;
#pragma unroll
            for (int j = 0; j < 4; ++j) { const f32x4 y = xv[j] * rs2 * gq[j]; o8[64 * j] = (unsigned long long)pk2(y.x, y.y) | ((unsigned long long)pk2(y.z, y.w) << 32); }
        }
    }
}

__device__ __forceinline__ int t5_bucket(int d) {
    if (d < 16) return d;
    return 16 + (d >= 19) + (d >= 21) + (d >= 24) + (d >= 27) + (d >= 31) + (d >= 35) + (d >= 40) + (d >= 46) + (d >= 52) + (d >= 59) + (d >= 67) + (d >= 77) + (d >= 87) + (d >= 99) + (d >= 113);
}
__device__ __forceinline__ void gla_naive(Frame& F) {
    LAS float* L = (LAS float*)(F.lds + RING_OFF);
    LAS float* qs = L;
    LAS float* ks = L + 4096;
    LAS float* adec = L + 8192;
    LAS float* vs = L + 12288;
    LAS float* os = L + 14336;
    for (int u = blockIdx.x; u < BATCH * GH * 4; u += F.G) {
        const int b = u / 16, h = (u / 4) % 4, e0 = (u % 4) * 32;
        float S[32];
#pragma unroll
        for (int i = 0; i < 32; ++i) S[i] = 0.f;
        for (int c = 0; c < SEQ / 64; ++c) {
            const int tok0 = b * SEQ + c * 64;
            {
                const int tt = F.tid >> 3, d0 = (F.tid & 7) * 8; const size_t tok = (size_t)tok0 + tt;
                const v4u qw = *(const GAS v4u*)(F.QB + tok * 256 + h * 64 + d0), kw = *(const GAS v4u*)(F.KB + tok * 256 + h * 64 + d0);
                LAS float* qd = qs + tt * 64 + d0; LAS float* kd = ks + tt * 64 + d0;
                qd[0] = pg8::bf_lo(qw.x); qd[1] = pg8::bf_hi(qw.x); qd[2] = pg8::bf_lo(qw.y); qd[3] = pg8::bf_hi(qw.y); qd[4] = pg8::bf_lo(qw.z); qd[5] = pg8::bf_hi(qw.z); qd[6] = pg8::bf_lo(qw.w); qd[7] = pg8::bf_hi(qw.w);
                kd[0] = pg8::bf_lo(kw.x); kd[1] = pg8::bf_hi(kw.x); kd[2] = pg8::bf_lo(kw.y); kd[3] = pg8::bf_hi(kw.y); kd[4] = pg8::bf_lo(kw.z); kd[5] = pg8::bf_hi(kw.z); kd[6] = pg8::bf_lo(kw.w); kd[7] = pg8::bf_hi(kw.w);
                float z[8];
#pragma unroll
                for (int i = 0; i < 8; ++i) z[i] = F.b_alpha[h * 64 + d0 + i];
#pragma unroll
                for (int r = 0; r < GRANK; ++r) { const float a = F.ALR[tok * 16 + r];
#pragma unroll
                    for (int i = 0; i < 8; ++i) z[i] += a * F.w_alpha[r * 256 + h * 64 + d0 + i]; }
#pragma unroll
                for (int i = 0; i < 8; ++i) { const float ls = fminf(z[i], 0.f) - log1pf(expf(-fabsf(z[i]))); adec[tt * 64 + d0 + i] = expf(ls * (1.f / 16.f)); }
                const int vt = F.tid >> 3, ve = (F.tid & 7) * 4;
                const unsigned long long vw = *(const GAS unsigned long long*)(F.VB + ((size_t)tok0 + vt) * 512 + h * 128 + e0 + ve);
                const unsigned vlo = (unsigned)vw, vhi = (unsigned)(vw >> 32);
                LAS float* vd = vs + vt * 32 + ve; vd[0] = pg8::bf_lo(vlo); vd[1] = pg8::bf_hi(vlo); vd[2] = pg8::bf_lo(vhi); vd[3] = pg8::bf_hi(vhi);
            }
            __syncthreads();
            if (F.wave == 0) {
                const int e = F.lane & 31, hf = F.lane >> 5;
                for (int t = 0; t < 64; ++t) {
                    const float v = vs[t * 32 + e]; float acc = 0.f;
                    const LAS float* ap = adec + t * 64 + hf * 32; const LAS float* kp = ks + t * 64 + hf * 32; const LAS float* qp = qs + t * 64 + hf * 32;
#pragma unroll
                    for (int dd = 0; dd < 32; ++dd) { S[dd] = ap[dd] * S[dd] + kp[dd] * v; acc += qp[dd] * S[dd]; }
                    acc += __shfl_xor(acc, 32);
                    if (hf == 0) os[t * 32 + e] = acc;
                }
            }
            __syncthreads();
            { const int vt = F.tid >> 3, ve = (F.tid & 7) * 4; const LAS float* od = os + vt * 32 + ve;
              *(GAS f32x4*)(F.OG + ((size_t)tok0 + vt) * 512 + h * 128 + e0 + ve) = (f32x4){od[0], od[1], od[2], od[3]}; }
        }
    }
}
__device__ __forceinline__ void attn_naive(Frame& F) {
    LAS float* btab = (LAS float*)(F.lds + RING_OFF) + 16384;
    __syncthreads();
    for (int i = F.tid; i < NQH * 128; i += NWAVES * 64) { const int h = i >> 7, d = i & 127; btab[i] = F.rel_bias[t5_bucket(d) * NQH + h] * LOG2E; }
    __syncthreads();
    for (int item = blockIdx.x * (NWAVES * 64) + F.tid; item < M * NQH; item += F.G * NWAVES * 64) {
        const int h = item / M, tok = item % M, p = tok % SEQ, kvh = h / (NQH / NKVH);
        float q[64], o[64];
        { const GAS v4u* qp = (const GAS v4u*)(F.QA + (size_t)tok * 512 + h * 64);
#pragma unroll
          for (int j = 0; j < 8; ++j) { const v4u w = qp[j]; q[8 * j + 0] = pg8::bf_lo(w.x); q[8 * j + 1] = pg8::bf_hi(w.x); q[8 * j + 2] = pg8::bf_lo(w.y); q[8 * j + 3] = pg8::bf_hi(w.y);
              q[8 * j + 4] = pg8::bf_lo(w.z); q[8 * j + 5] = pg8::bf_hi(w.z); q[8 * j + 6] = pg8::bf_lo(w.w); q[8 * j + 7] = pg8::bf_hi(w.w); } }
#pragma unroll
        for (int j = 0; j < 64; ++j) o[j] = 0.f;
        float mrun = F.sinks[h] * LOG2E, l = 1.f;
        const int nd = p < WINDOW - 1 ? p : WINDOW - 1;
        for (int d = 0; d <= nd; ++d) {
            const GAS v4u* kp = (const GAS v4u*)(F.KV + (size_t)(tok - d) * 256 + kvh * 64);
            float s = 0.f;
#pragma unroll
            for (int j = 0; j < 8; ++j) { const v4u w = kp[j];
                s += q[8 * j + 0] * pg8::bf_lo(w.x) + q[8 * j + 1] * pg8::bf_hi(w.x) + q[8 * j + 2] * pg8::bf_lo(w.y) + q[8 * j + 3] * pg8::bf_hi(w.y)
                   + q[8 * j + 4] * pg8::bf_lo(w.z) + q[8 * j + 5] * pg8::bf_hi(w.z) + q[8 * j + 6] * pg8::bf_lo(w.w) + q[8 * j + 7] * pg8::bf_hi(w.w); }
            s += btab[h * 128 + d];
            const float mn = fmaxf(mrun, s), al = exp2f(mrun - mn), pe = exp2f(s - mn);
            l = l * al + pe; mrun = mn;
            const GAS v4u* vp = (const GAS v4u*)(F.KV + (size_t)(tok - d) * 256 + 128 + kvh * 64);
#pragma unroll
            for (int j = 0; j < 8; ++j) { const v4u w = vp[j];
                o[8 * j + 0] = o[8 * j + 0] * al + pe * pg8::bf_lo(w.x); o[8 * j + 1] = o[8 * j + 1] * al + pe * pg8::bf_hi(w.x);
                o[8 * j + 2] = o[8 * j + 2] * al + pe * pg8::bf_lo(w.y); o[8 * j + 3] = o[8 * j + 3] * al + pe * pg8::bf_hi(w.y);
                o[8 * j + 4] = o[8 * j + 4] * al + pe * pg8::bf_lo(w.z); o[8 * j + 5] = o[8 * j + 5] * al + pe * pg8::bf_hi(w.z);
                o[8 * j + 6] = o[8 * j + 6] * al + pe * pg8::bf_lo(w.w); o[8 * j + 7] = o[8 * j + 7] * al + pe * pg8::bf_hi(w.w); }
        }
        const float il = 1.f / l;
        GAS v4u* yp = (GAS v4u*)(F.HN + (size_t)tok * D + h * 64);
#pragma unroll
        for (int j = 0; j < 8; ++j) { v4u w; w.x = pk2(o[8 * j + 0] * il, o[8 * j + 1] * il); w.y = pk2(o[8 * j + 2] * il, o[8 * j + 3] * il); w.z = pk2(o[8 * j + 4] * il, o[8 * j + 5] * il); w.w = pk2(o[8 * j + 6] * il, o[8 * j + 7] * il); yp[j] = w; }
    }
}
__device__ __forceinline__ void gla_post(Frame& F) {
    const int gw = F.vcu * NWAVES + F.wave, NGW = F.G * NWAVES;
    const int e = (F.lane & 15) * 8;
    const f32x4 g0 = *(const GAS f32x4*)(F.gla_g + e), g1 = *(const GAS f32x4*)(F.gla_g + e + 4);
    for (int m = gw; m < M; m += NGW) {
        const GAS f32x4* op = (const GAS f32x4*)(F.OG + (size_t)m * 512 + F.lane * 8);
        const f32x4 a = op[0], b = op[1];
        float s = (a.x * a.x + a.y * a.y) + (a.z * a.z + a.w * a.w) + (b.x * b.x + b.y * b.y) + (b.z * b.z + b.w * b.w);
        s += __shfl_xor(s, 1); s += __shfl_xor(s, 2); s += __shfl_xor(s, 4); s += __shfl_xor(s, 8);
        const float rs = 1.f / sqrtf(s * (1.f / GDV) + EPS);
        const v4u rw = *(const GAS v4u*)(F.RB + (size_t)m * 512 + F.lane * 8);
        const f32x4 ya = a * rs * g0, yb = b * rs * g1;
        v4u w; w.x = pk2(ya.x * pg8::bf_lo(rw.x), ya.y * pg8::bf_hi(rw.x)); w.y = pk2(ya.z * pg8::bf_lo(rw.y), ya.w * pg8::bf_hi(rw.y));
        w.z = pk2(yb.x * pg8::bf_lo(rw.z), yb.y * pg8::bf_hi(rw.z)); w.w = pk2(yb.z * pg8::bf_lo(rw.w), yb.w * pg8::bf_hi(rw.w));
        *(GAS v4u*)(F.HN + (size_t)m * D + 512 + F.lane * 8) = w;
    }
}


namespace mix {
typedef short bf16x8 __attribute__((ext_vector_type(8)));
typedef short s16x4 __attribute__((ext_vector_type(4)));
typedef float f32x16 __attribute__((ext_vector_type(16)));
typedef float f32x2_t __attribute__((ext_vector_type(2)));
typedef __bf16 bf16x2_t __attribute__((ext_vector_type(2)));
#define MIX_DI __device__ __forceinline__
#define MFMA32(a, b, c) __builtin_amdgcn_mfma_f32_32x32x16_bf16((a), (b), (c), 0, 0, 0)
MIX_DI unsigned cvtpk(float lo, float hi) { f32x2_t v = {lo, hi}; bf16x2_t b = __builtin_convertvector(v, bf16x2_t); return __builtin_bit_cast(unsigned, b); }
MIX_DI int crow(int r, int hi) { return (r & 3) + 8 * (r >> 2) + 4 * hi; }
template <int S8> MIX_DI bf16x8 pack8(const f32x16& x) {
    v4u p; p.x = cvtpk(x[8 * S8 + 0], x[8 * S8 + 1]); p.y = cvtpk(x[8 * S8 + 2], x[8 * S8 + 3]); p.z = cvtpk(x[8 * S8 + 4], x[8 * S8 + 5]); p.w = cvtpk(x[8 * S8 + 6], x[8 * S8 + 7]);
    return __builtin_bit_cast(bf16x8, p);
}
MIX_DI bf16x8 join8(const s16x4 lo, const s16x4 hi) { return __builtin_shufflevector(lo, hi, 0, 1, 2, 3, 4, 5, 6, 7); }
MIX_DI float ex2(float x) { return __builtin_amdgcn_exp2f(x); }

constexpr int ATT_KT = 0, ATT_KP = 144;
constexpr int ATT_VT = 27648, ATT_VP = 392;
constexpr int ATT_BT = 53248;
constexpr int ATT_END = ATT_BT + 8 * 192 * 4;
MIX_DI void attn_bias_table(Frame& F) {
    LAS float* BT = (LAS float*)(F.lds + RING_OFF + ATT_BT);
    for (int i = F.tid; i < NQH * 192; i += NWAVES * 64) { const int h = i / 192, dist = i % 192 - 32;
        BT[i] = (dist >= 0 && dist < WINDOW) ? F.rel_bias[t5_bucket(dist) * NQH + h] * LOG2E : -__builtin_inff(); }
}
MIX_DI void attn_unit(Frame& F, int b, int kvh, int qt) {
    LAS unsigned char* KT = F.lds + RING_OFF + ATT_KT; LAS unsigned char* VT = F.lds + RING_OFF + ATT_VT; const LAS float* BT = (const LAS float*)(F.lds + RING_OFF + ATT_BT);
    const int p0 = qt * 64, kt0 = p0 - 128; const size_t rowbase = (size_t)b * SEQ;
#pragma unroll
    for (int i = 0; i < 3; ++i) { const int c = F.tid + 512 * i, row = c >> 3, ch = c & 7, kp = kt0 + row;
        v4u kw = (v4u){0u, 0u, 0u, 0u}, vw = (v4u){0u, 0u, 0u, 0u};
        if (kp >= 0) { const bf16* src = F.KV + (rowbase + kp) * 256 + kvh * 64 + ch * 8; kw = *(const GAS v4u*)src; vw = *(const GAS v4u*)(src + 128); }
        *(LAS v4u*)(KT + row * ATT_KP + ch * 16) = kw;
        LAS unsigned short* vt = (LAS unsigned short*)(VT + (ch * 8) * ATT_VP) + row;
        vt[0 * (ATT_VP / 2)] = (unsigned short)(vw.x & 0xffffu); vt[1 * (ATT_VP / 2)] = (unsigned short)(vw.x >> 16);
        vt[2 * (ATT_VP / 2)] = (unsigned short)(vw.y & 0xffffu); vt[3 * (ATT_VP / 2)] = (unsigned short)(vw.y >> 16);
        vt[4 * (ATT_VP / 2)] = (unsigned short)(vw.z & 0xffffu); vt[5 * (ATT_VP / 2)] = (unsigned short)(vw.z >> 16);
        vt[6 * (ATT_VP / 2)] = (unsigned short)(vw.w & 0xffffu); vt[7 * (ATT_VP / 2)] = (unsigned short)(vw.w >> 16); }
    const int g = F.wave >> 1, half = F.wave & 1, hq = kvh * (NQH / NKVH) + g, jl = F.lane & 31, hh = F.lane >> 5;
    const size_t qrow = rowbase + p0 + 32 * half + jl;
    bf16x8 qf[4];
    { const bf16* qp = F.QA + qrow * 512 + hq * 64 + 8 * hh;
#pragma unroll
      for (int ks = 0; ks < 4; ++ks) qf[ks] = *(const GAS bf16x8*)(qp + 16 * ks); }
    __syncthreads();
    f32x16 S[5];
#pragma unroll
    for (int bi = 0; bi < 5; ++bi) { const int blk = half + bi;
#pragma unroll
        for (int r = 0; r < 16; ++r) { const int i = crow(r, hh); float c = BT[hq * 192 + 160 - 32 * bi + jl - i]; if (kt0 < 0 && kt0 + 32 * blk + i < 0) c = -__builtin_inff(); S[bi][r] = c; }
#pragma unroll
        for (int ks = 0; ks < 4; ++ks) { const bf16x8 kf = *(const LAS bf16x8*)(KT + (32 * blk + jl) * ATT_KP + (2 * ks + hh) * 16); S[bi] = MFMA32(kf, qf[ks], S[bi]); } }
    const float sk = F.sinks[hq] * LOG2E;
    float m = sk;
#pragma unroll
    for (int bi = 0; bi < 5; ++bi)
#pragma unroll
        for (int r = 0; r < 16; ++r) m = fmaxf(m, S[bi][r]);
    m = fmaxf(m, __shfl_xor(m, 32));
    float l = 0.f;
#pragma unroll
    for (int bi = 0; bi < 5; ++bi)
#pragma unroll
        for (int r = 0; r < 16; ++r) { const float p = ex2(S[bi][r] - m); S[bi][r] = p; l += p; }
    l += __shfl_xor(l, 32); l += ex2(sk - m);
    f32x16 O0, O1;
#pragma unroll
    for (int r = 0; r < 16; ++r) { O0[r] = 0.f; O1[r] = 0.f; }
#define ATT_PV(bi, s2) do { const bf16x8 pb = pack8<s2>(S[bi]); const int ko = (32 * (half + bi) + 16 * s2 + 4 * hh) * 2; \
        const LAS unsigned char* v0 = VT + jl * ATT_VP + ko; const LAS unsigned char* v1 = VT + (32 + jl) * ATT_VP + ko; \
        O0 = MFMA32(join8(*(const LAS s16x4*)v0, *(const LAS s16x4*)(v0 + 16)), pb, O0); O1 = MFMA32(join8(*(const LAS s16x4*)v1, *(const LAS s16x4*)(v1 + 16)), pb, O1); } while (0)
    ATT_PV(0, 0); ATT_PV(0, 1); ATT_PV(1, 0); ATT_PV(1, 1); ATT_PV(2, 0); ATT_PV(2, 1); ATT_PV(3, 0); ATT_PV(3, 1); ATT_PV(4, 0); ATT_PV(4, 1);
#undef ATT_PV
    const float il = 1.f / l;
    bf16* yp = F.HN + qrow * D + hq * 64 + 4 * hh;
#pragma unroll
    for (int gq = 0; gq < 4; ++gq) {
        *(GAS unsigned long long*)(yp + 8 * gq) = (unsigned long long)cvtpk(O0[4 * gq] * il, O0[4 * gq + 1] * il) | ((unsigned long long)cvtpk(O0[4 * gq + 2] * il, O0[4 * gq + 3] * il) << 32);
        *(GAS unsigned long long*)(yp + 32 + 8 * gq) = (unsigned long long)cvtpk(O1[4 * gq] * il, O1[4 * gq + 1] * il) | ((unsigned long long)cvtpk(O1[4 * gq + 2] * il, O1[4 * gq + 3] * il) << 32); }
    __syncthreads();
}
}


namespace mix {
constexpr int GL_P = 144;
constexpr int GL_QD = 0, GL_KI = 9216, GL_KST = 18432, GL_VT = 27648;
constexpr int GL_TOT = 46080, GL_DEC = 48128, GL_SSX = 48384, GL_END = 49408;
MIX_DI unsigned short bf1(float x) { return (unsigned short)(cvtpk(x, x) & 0xffffu); }
MIX_DI void gla_chain(Frame& F, int b, int h) {
    LAS unsigned char* L = F.lds + RING_OFF;
    LAS unsigned char* QD = L + GL_QD; LAS unsigned char* KI = L + GL_KI; LAS unsigned char* KST = L + GL_KST; LAS unsigned char* VT = L + GL_VT;
    LAS float* TOT = (LAS float*)(L + GL_TOT); LAS float* DEC = (LAS float*)(L + GL_DEC); LAS float* SSX = (LAS float*)(L + GL_SSX);
    const int w = F.wave, d = F.lane, eb = w >> 1, tt = w & 1, jl = F.lane & 31, hh = F.lane >> 5, tl = 32 * tt + jl;
    float wa[16];
#pragma unroll
    for (int r = 0; r < GRANK; ++r) wa[r] = F.w_alpha[r * 256 + h * 64 + d];
    const float ba = F.b_alpha[h * 64 + d];
    float gg[16];
#pragma unroll
    for (int r = 0; r < 16; ++r) gg[r] = F.gla_g[32 * eb + crow(r, hh)];
    f32x16 S0, S1;
#pragma unroll
    for (int r = 0; r < 16; ++r) { S0[r] = 0.f; S1[r] = 0.f; }
    for (int c = 0; c < SEQ / 64; ++c) {
        const size_t tok0 = (size_t)b * SEQ + c * 64;
        float pb[8]; unsigned short qraw[8], kraw[8]; float run = 0.f;
#pragma unroll
        for (int i = 0; i < 8; ++i) { const size_t tok = tok0 + 8 * w + i; const float* ar = F.ALR + tok * 16; float z = ba;
#pragma unroll
            for (int r = 0; r < GRANK; ++r) z += ar[r] * wa[r];
            const float ls = fminf(z, 0.f) - log1pf(expf(-fabsf(z))); run += ls * (1.f / 16.f); pb[i] = run;
            qraw[i] = *(const GAS unsigned short*)(F.QB + tok * 256 + h * 64 + d); kraw[i] = *(const GAS unsigned short*)(F.KB + tok * 256 + h * 64 + d); }
        TOT[w * 64 + d] = run;
        v4u vw[2];
#pragma unroll
        for (int i = 0; i < 2; ++i) { const int cidx = F.tid + 512 * i; vw[i] = *(const GAS v4u*)(F.VB + (tok0 + (cidx >> 4)) * 512 + h * 128 + (cidx & 15) * 8); }
        __syncthreads();
        float off = 0.f, tot = 0.f;
#pragma unroll
        for (int ww = 0; ww < 8; ++ww) { const float x = TOT[ww * 64 + d]; tot += x; off += (ww < w) ? x : 0.f; }
        { v4u kst; unsigned short ksv[8];
#pragma unroll
          for (int i = 0; i < 8; ++i) { const float bb = off + pb[i]; const float q = __uint_as_float((unsigned)qraw[i] << 16), k = __uint_as_float((unsigned)kraw[i] << 16);
              const float eb_ = ex2(bb * LOG2E), en = ex2(-bb * LOG2E), es = ex2((tot - bb) * LOG2E);
              *(LAS unsigned short*)(QD + (8 * w + i) * GL_P + d * 2) = bf1(q * eb_);
              *(LAS unsigned short*)(KI + (8 * w + i) * GL_P + d * 2) = bf1(k * en);
              ksv[i] = bf1(k * es); }
          kst.x = (unsigned)ksv[0] | ((unsigned)ksv[1] << 16); kst.y = (unsigned)ksv[2] | ((unsigned)ksv[3] << 16); kst.z = (unsigned)ksv[4] | ((unsigned)ksv[5] << 16); kst.w = (unsigned)ksv[6] | ((unsigned)ksv[7] << 16);
          *(LAS v4u*)(KST + d * GL_P + w * 16) = kst; }
        if (w == 0) DEC[d] = ex2(tot * LOG2E);
#pragma unroll
        for (int i = 0; i < 2; ++i) { const int cidx = F.tid + 512 * i, t = cidx >> 4, ec = cidx & 15;
            LAS unsigned short* vt = (LAS unsigned short*)(VT + (ec * 8) * GL_P) + t;
            vt[0 * (GL_P / 2)] = (unsigned short)(vw[i].x & 0xffffu); vt[1 * (GL_P / 2)] = (unsigned short)(vw[i].x >> 16);
            vt[2 * (GL_P / 2)] = (unsigned short)(vw[i].y & 0xffffu); vt[3 * (GL_P / 2)] = (unsigned short)(vw[i].y >> 16);
            vt[4 * (GL_P / 2)] = (unsigned short)(vw[i].z & 0xffffu); vt[5 * (GL_P / 2)] = (unsigned short)(vw[i].z >> 16);
            vt[6 * (GL_P / 2)] = (unsigned short)(vw[i].w & 0xffffu); vt[7 * (GL_P / 2)] = (unsigned short)(vw[i].w >> 16); }
        __syncthreads();
        bf16x8 qn[4];
#pragma unroll
        for (int ks = 0; ks < 4; ++ks) qn[ks] = *(const LAS bf16x8*)(QD + tl * GL_P + (2 * ks + hh) * 16);
        f32x16 X0, X1, O;
#pragma unroll
        for (int r = 0; r < 16; ++r) { X0[r] = 0.f; X1[r] = 0.f; O[r] = 0.f; }
#pragma unroll
        for (int ks = 0; ks < 4; ++ks) X0 = MFMA32(*(const LAS bf16x8*)(KI + jl * GL_P + (2 * ks + hh) * 16), qn[ks], X0);
        if (tt == 1) {
#pragma unroll
            for (int ks = 0; ks < 4; ++ks) X1 = MFMA32(*(const LAS bf16x8*)(KI + (32 + jl) * GL_P + (2 * ks + hh) * 16), qn[ks], X1);
#pragma unroll
            for (int r = 0; r < 16; ++r) if (crow(r, hh) > jl) X1[r] = 0.f;
        } else {
#pragma unroll
            for (int r = 0; r < 16; ++r) if (crow(r, hh) > jl) X0[r] = 0.f;
        }
        { const LAS unsigned char* qp = QD + tl * GL_P + 8 * hh;
          O = MFMA32(pack8<0>(S0), join8(*(const LAS s16x4*)(qp + 0), *(const LAS s16x4*)(qp + 16)), O);
          O = MFMA32(pack8<1>(S0), join8(*(const LAS s16x4*)(qp + 32), *(const LAS s16x4*)(qp + 48)), O);
          O = MFMA32(pack8<0>(S1), join8(*(const LAS s16x4*)(qp + 64), *(const LAS s16x4*)(qp + 80)), O);
          O = MFMA32(pack8<1>(S1), join8(*(const LAS s16x4*)(qp + 96), *(const LAS s16x4*)(qp + 112)), O); }
        { const LAS unsigned char* vp = VT + (32 * eb + jl) * GL_P + 8 * hh;
          O = MFMA32(join8(*(const LAS s16x4*)(vp + 0), *(const LAS s16x4*)(vp + 16)), pack8<0>(X0), O);
          O = MFMA32(join8(*(const LAS s16x4*)(vp + 32), *(const LAS s16x4*)(vp + 48)), pack8<1>(X0), O);
          if (tt == 1) {
              O = MFMA32(join8(*(const LAS s16x4*)(vp + 64), *(const LAS s16x4*)(vp + 80)), pack8<0>(X1), O);
              O = MFMA32(join8(*(const LAS s16x4*)(vp + 96), *(const LAS s16x4*)(vp + 112)), pack8<1>(X1), O); } }
#pragma unroll
        for (int gq = 0; gq < 4; ++gq) { const f32x4 d0 = *(const LAS f32x4*)(DEC + 8 * gq + 4 * hh), d1 = *(const LAS f32x4*)(DEC + 32 + 8 * gq + 4 * hh);
#pragma unroll
            for (int i = 0; i < 4; ++i) { S0[4 * gq + i] *= d0[i]; S1[4 * gq + i] *= d1[i]; } }
#pragma unroll
        for (int ks = 0; ks < 4; ++ks) { const bf16x8 vb = *(const LAS bf16x8*)(VT + (32 * eb + jl) * GL_P + (2 * ks + hh) * 16);
            S0 = MFMA32(*(const LAS bf16x8*)(KST + jl * GL_P + (2 * ks + hh) * 16), vb, S0);
            S1 = MFMA32(*(const LAS bf16x8*)(KST + (32 + jl) * GL_P + (2 * ks + hh) * 16), vb, S1); }
        float ss = 0.f;
#pragma unroll
        for (int r = 0; r < 16; ++r) ss += O[r] * O[r];
        ss += __shfl_xor(ss, 32);
        if (hh == 0) SSX[eb * 64 + tl] = ss;
        __syncthreads();
        const float rs = 1.f / sqrtf((SSX[tl] + SSX[64 + tl] + SSX[128 + tl] + SSX[192 + tl]) * (1.f / GDV) + EPS);
        const size_t tok = tok0 + tl;
#pragma unroll
        for (int gq = 0; gq < 4; ++gq) { const int e = h * 128 + 32 * eb + 8 * gq + 4 * hh;
            const unsigned long long rw = *(const GAS unsigned long long*)(F.RB + tok * 512 + e); const unsigned rlo = (unsigned)rw, rhi = (unsigned)(rw >> 32);
            const float y0 = O[4 * gq + 0] * rs * gg[4 * gq + 0] * pg8::bf_lo(rlo), y1 = O[4 * gq + 1] * rs * gg[4 * gq + 1] * pg8::bf_hi(rlo);
            const float y2 = O[4 * gq + 2] * rs * gg[4 * gq + 2] * pg8::bf_lo(rhi), y3 = O[4 * gq + 3] * rs * gg[4 * gq + 3] * pg8::bf_hi(rhi);
            *(GAS unsigned long long*)(F.HN + tok * D + 512 + e) = (unsigned long long)cvtpk(y0, y1) | ((unsigned long long)cvtpk(y2, y3) << 32); }
    }
    __syncthreads();
}
}

struct Args { const float* in[22]; float* out; unsigned char* ws; int ph_lo, ph_hi; };
__global__ void __launch_bounds__(NWAVES * 64, 2) mk_fwd(Args args) {
    extern __shared__ __attribute__((aligned(16))) unsigned char lds[];
    Frame F;
    F.lds = (LAS unsigned char*)lds;
    F.MISC = (volatile LAS unsigned*)(F.lds + MISC_OFF);
    F.tid = threadIdx.x; F.lane = F.tid & 63; F.wave = __builtin_amdgcn_readfirstlane(F.tid >> 6);
    F.G = gridDim.x; { const int bx = blockIdx.x; F.vcu = (F.G % 8 == 0) ? (bx % 8) * (F.G / 8) + bx / 8 : bx; }
    unsigned char* ws = args.ws;
    F.ctl = (gu32*)(ws + WS_CTL);
    F.x = args.in[0]; F.rel_bias = args.in[1]; F.f1_pre_g = args.in[2]; F.f1_wg = args.in[3]; F.f1_wu = args.in[4]; F.f1_wd = args.in[5]; F.f1_post_g = args.in[6];
    F.mix_pre_g = args.in[7]; F.w_in = args.in[8]; F.w_alpha = args.in[9]; F.b_alpha = args.in[10]; F.sinks = args.in[11]; F.gla_g = args.in[12];
    F.w_pa = args.in[13]; F.w_pb = args.in[14]; F.w_out = args.in[15]; F.mix_post_g = args.in[16];
    F.f2_pre_g = args.in[17]; F.f2_wg = args.in[18]; F.f2_wu = args.in[19]; F.f2_wd = args.in[20]; F.f2_post_g = args.in[21];
    F.out = args.out;
    F.W1GU = (bf16*)(ws + WS_W1GU); F.W1D = (bf16*)(ws + WS_W1D); F.W2GU = (bf16*)(ws + WS_W2GU); F.W2D = (bf16*)(ws + WS_W2D);
    F.WIN = (bf16*)(ws + WS_WIN); F.WPAB = (bf16*)(ws + WS_WPAB); F.WOUT = (bf16*)(ws + WS_WOUT);
    F.HN = (bf16*)(ws + WS_HN); F.FB = (bf16*)(ws + WS_F); F.HB = (bf16*)(ws + WS_BIG);
    F.QA = (bf16*)(ws + WS_QA); F.KV = (bf16*)(ws + WS_KV); F.QB = (bf16*)(ws + WS_QB); F.KB = (bf16*)(ws + WS_KB); F.VB = (bf16*)(ws + WS_VB); F.RB = (bf16*)(ws + WS_RB);
    F.GA = (bf16*)(ws + WS_GA); F.GB = (bf16*)(ws + WS_GB); F.MO = (bf16*)(ws + WS_MO);
    F.ALR = (float*)(ws + WS_ALR); F.OG = (float*)(ws + WS_F);
    for (int u = F.tid; u < (LDS_BYTES - LDSCTL_OFF) / 4; u += NWAVES * 64) ((LAS unsigned*)(F.lds + LDSCTL_OFF))[u] = 0u;
    __syncthreads();
    XcdBarrier bar; bar.bar = (unsigned*)(F.ctl + CW_BAR); bar.x = 0; bar.st = nullptr;
    if (N_LAUNCHES == 1) bar = xcd_barrier_post((unsigned*)(F.ctl + CW_BAR), F.MISC + 8);
#define GRID_BAR() do { if (N_LAUNCHES == 1) xcd_barrier(bar); } while (0)
    const int lo = args.ph_lo, hi = args.ph_hi;
#define IN(k) (lo <= (k) && (k) < hi)
#define SEAM(k) do { if (IN(k) && IN((k) + 1)) GRID_BAR(); } while (0)
    typedef pg8::bf16_t bt;

    if (IN(0)) { p0_prologue(F); } SEAM(0);
    if (IN(1)) { pg8::Gemm g{(const bt*)F.HN, (const bt*)F.W1GU, M, 2 * FF, D, D, D}; pg8::StaticOrder S; S.init(M, 2 * FF, F.G, (int)blockIdx.x);
        pg8::EpiSwiglu E{(bt*)F.HB, FF}; pg8::gemm_phase<pg8::EpiSwiglu, pg8::StaticOrder, true, true>(F.lds + RING_OFF, g, S, E); } SEAM(1);
    if (IN(2)) { pg8::Gemm g{(const bt*)F.HB, (const bt*)F.W1D, M, D, FF, FF, FF}; pg8::StaticOrder S; S.init(M, D, F.G, (int)blockIdx.x);
        pg8::EpiStore E{(bt*)F.FB, D}; pg8::gemm_phase<pg8::EpiStore, pg8::StaticOrder, true, true>(F.lds + RING_OFF, g, S, E); } SEAM(2);
    if (IN(3)) { thin_norm<true>(F, F.FB, F.x, F.out, 0.5f, F.f1_post_g, F.HN, F.mix_pre_g); } SEAM(3);
    if (IN(4)) { pg8::Gemm g{(const bt*)F.HN, (const bt*)F.WIN, M, NIN, D, D, D}; pg8::StaticOrder S; S.init(M, NIN, F.G, (int)blockIdx.x);
        pg8::EpiIn E{(bt*)F.QA, (bt*)F.KV, (bt*)F.QB, (bt*)F.KB, (bt*)F.VB, (bt*)F.RB, (bt*)F.GA, (bt*)F.GB, F.ALR, 0.125f * LOG2E, 0.125f};
        pg8::gemm_phase<pg8::EpiIn, pg8::StaticOrder, true, true>(F.lds + RING_OFF, g, S, E); } SEAM(4);
    if (IN(5)) {
#if FAST_GLA
        if (F.G >= 128) {
            if (blockIdx.x < BATCH * GH) mix::gla_chain(F, blockIdx.x >> 2, blockIdx.x & 3);
            else { mix::attn_bias_table(F); __syncthreads();
                for (int u = blockIdx.x - BATCH * GH; u < BATCH * NKVH * (SEQ / 64); u += F.G - BATCH * GH) mix::attn_unit(F, u / 64, (u / 32) & 1, u & 31); }
        } else {
            for (int u = blockIdx.x; u < BATCH * GH; u += F.G) mix::gla_chain(F, u >> 2, u & 3);
            mix::attn_bias_table(F); __syncthreads();
            for (int u = blockIdx.x; u < BATCH * NKVH * (SEQ / 64); u += F.G) mix::attn_unit(F, u / 64, (u / 32) & 1, u & 31);
        }
#else
        gla_naive(F);
        __syncthreads();
        mix::attn_bias_table(F); __syncthreads();
        for (int u = blockIdx.x; u < BATCH * NKVH * (SEQ / 64); u += F.G) mix::attn_unit(F, u / 64, (u / 32) & 1, u & 31);
#endif
    } SEAM(5);
#if !FAST_GLA
    if (IN(6)) { gla_post(F); } SEAM(6);
#endif
    if (IN(7)) { pg8::Gemm g{(const bt*)F.HN, (const bt*)F.WPAB, M, D, 512, D, D}; pg8::StaticOrder S; S.init(M, D, F.G, (int)blockIdx.x);
        pg8::EpiGate<false> E{(const bt*)F.GA, (bt*)F.FB}; pg8::gemm_phase<pg8::EpiGate<false>, pg8::StaticOrder, true, true>(F.lds + RING_OFF, g, S, E); } SEAM(7);
    if (IN(8)) { pg8::Gemm g{(const bt*)F.HN + 512, (const bt*)F.WPAB + 512, M, D, 512, D, D}; pg8::StaticOrder S; S.init(M, D, F.G, (int)blockIdx.x);
        pg8::EpiGate<true> E{(const bt*)F.GB, (bt*)F.FB}; pg8::gemm_phase<pg8::EpiGate<true>, pg8::StaticOrder, true, true>(F.lds + RING_OFF, g, S, E); } SEAM(8);
    if (IN(9)) { pg8::Gemm g{(const bt*)F.FB, (const bt*)F.WOUT, M, D, D, D, D}; pg8::StaticOrder S; S.init(M, D, F.G, (int)blockIdx.x);
        pg8::EpiStore E{(bt*)F.MO, D}; pg8::gemm_phase<pg8::EpiStore, pg8::StaticOrder, true, true>(F.lds + RING_OFF, g, S, E); } SEAM(9);
    if (IN(10)) { thin_norm<true>(F, F.MO, F.out, F.out, 1.0f, F.mix_post_g, F.HN, F.f2_pre_g); } SEAM(10);
    if (IN(11)) { pg8::Gemm g{(const bt*)F.HN, (const bt*)F.W2GU, M, 2 * FF, D, D, D}; pg8::StaticOrder S; S.init(M, 2 * FF, F.G, (int)blockIdx.x);
        pg8::EpiSwiglu E{(bt*)F.HB, FF}; pg8::gemm_phase<pg8::EpiSwiglu, pg8::StaticOrder, true, true>(F.lds + RING_OFF, g, S, E); } SEAM(11);
    if (IN(12)) { pg8::Gemm g{(const bt*)F.HB, (const bt*)F.W2D, M, D, FF, FF, FF}; pg8::StaticOrder S; S.init(M, D, F.G, (int)blockIdx.x);
        pg8::EpiStore E{(bt*)F.FB, D}; pg8::gemm_phase<pg8::EpiStore, pg8::StaticOrder, true, true>(F.lds + RING_OFF, g, S, E); } SEAM(12);
    if (IN(13)) { thin_norm<false>(F, F.FB, F.out, F.out, 0.5f, F.f2_post_g, nullptr, nullptr); }
#undef IN
#undef SEAM
#undef GRID_BAR
}

extern "C" void kernel_launch(void* const* d_in, const int* in_sizes, int n_in, void* d_out, int out_size, void* d_ws, size_t ws_size, hipStream_t stream) {
    static int grid = 0;
    if (grid == 0) {
        if (n_in != 22 || in_sizes[0] != M * D || out_size != M * D || ws_size < WS_END || ws_size < WS_BIG + (size_t)M * FF * 2) {
            fprintf(stderr, "kernel_launch: shape/workspace mismatch: n_in %d in0 %d out %d ws %zu (need %zu)\n", n_in, n_in > 0 ? in_sizes[0] : -1, out_size, ws_size, (size_t)WS_END); grid = -1; return; }
        int dev = 0, cus = 0, per_cu = 0;
        if (hipGetDevice(&dev) != hipSuccess || hipDeviceGetAttribute(&cus, hipDeviceAttributeMultiprocessorCount, dev) != hipSuccess) { fprintf(stderr, "kernel_launch: device query failed\n"); grid = -1; return; }
        if (hipFuncSetAttribute((const void*)mk_fwd, hipFuncAttributeMaxDynamicSharedMemorySize, LDS_BYTES) != hipSuccess) { fprintf(stderr, "kernel_launch: hipFuncSetAttribute failed\n"); grid = -1; return; }
        if (hipOccupancyMaxActiveBlocksPerMultiprocessor(&per_cu, (const void*)mk_fwd, NWAVES * 64, LDS_BYTES) != hipSuccess || per_cu < 1)
            fprintf(stderr, "kernel_launch: note: occupancy query reports %d workgroups per CU\n", per_cu);
        (void)hipGetLastError();
        grid = cus;
    }
    if (grid < 0) return;
    if (hipMemsetAsync((char*)d_ws + WS_CTL, 0, CTL_ZERO_BYTES, stream) != hipSuccess) { fprintf(stderr, "kernel_launch: memset failed\n"); return; }
    Args a{};
    for (int i = 0; i < 22; ++i) a.in[i] = (const float*)d_in[i];
    a.out = (float*)d_out; a.ws = (unsigned char*)d_ws;
    for (int li = 0; li < N_LAUNCHES; ++li) {
        a.ph_lo = (N_LAUNCHES == 1) ? 0 : li; a.ph_hi = (N_LAUNCHES == 1) ? N_PHASES : li + 1;
        hipLaunchKernelGGL(mk_fwd, dim3(grid), dim3(NWAVES * 64), LDS_BYTES, stream, a);
        const hipError_t le = hipPeekAtLastError();
        if (le != hipSuccess) { fprintf(stderr, "kernel_launch: launch %d failed: %s\n", li, hipGetErrorName(le)); break; }
    }
}
```

```cpp
#include <hip/hip_runtime.h>
#include <cstdio>
#include <cstdint>
namespace pg8 {
#define PG8_LAS __attribute__((address_space(3)))
typedef unsigned short bf16_t;
typedef short bf16x8 __attribute__((ext_vector_type(8)));
typedef float f32x4 __attribute__((ext_vector_type(4)));
typedef unsigned u32x4 __attribute__((ext_vector_type(4)));
constexpr int BM = 256, BK = 64, HALF = 128, HTB = HALF * BK * 2  , STAGE_BYTES = 8 * HTB, NXCD = 8, WGM = 8;

__host__ __device__ __forceinline__ int lds_byte(int r, int c) { const int st = (r >> 4) * 2 + (c >> 5), rr = r & 15, cc = c & 31, ob = rr * 64 + cc * 2; return st * 1024 + (ob ^ (((ob >> 9) & 1) << 5)); }
__host__ __device__ __forceinline__ void stage_rc(int b, int& R, int& C) { const int st = b / 1024, sb = b % 1024, swz = sb ^ (((sb >> 9) & 1) << 5); R = (st >> 1) * 16 + swz / 64; C = (st & 1) * 32 + (swz % 64) / 2; }
__host__ __device__ __forceinline__ int perm32(int rho) { const int n = rho >> 4, i = rho & 15; return 8 * (i >> 2) + 4 * n + (i & 3); }

struct Unit { int pm, pn; };
struct Gemm { const bf16_t* A; const bf16_t* Bt; int M, N, K, lda, ldb; };

struct StaticOrder {
    int nM, nN, nwg, G, c;
    __host__ __device__ void init(int M, int N, int G_, int c_) { nM = M / BM; nN = N / BM; nwg = nM * nN; G = G_; c = c_; }
    __host__ __device__ bool next(int i, Unit& u) const {
        const long L = (long)i * G + c; if (L >= nwg) return false;
        int wgid = (int)L; { const int q = nwg / NXCD, r = nwg % NXCD, xcd = wgid % NXCD, off = wgid / NXCD; wgid = (xcd < r ? xcd * (q + 1) : r * (q + 1) + (xcd - r) * q) + off; }
        const int nig = WGM * nN, gid = wgid / nig, fm = gid * WGM, gsz = (nM - fm) < WGM ? (nM - fm) : WGM;
        u.pm = fm + ((wgid % nig) % gsz); u.pn = (wgid % nig) / gsz; return true;
    }
    __device__ __forceinline__ void a_ready(const Unit&) const {}
    __device__ __forceinline__ void done(const Unit&) const {}
};

__device__ __forceinline__ unsigned cvt_pk_bf16(float lo, float hi) { unsigned r; asm volatile("v_cvt_pk_bf16_f32 %0, %1, %2" : "=v"(r) : "v"(lo), "v"(hi)); return r; }
typedef float f32x2 __attribute__((ext_vector_type(2)));

__device__ __forceinline__ float bf_lo(unsigned w) { return __uint_as_float(w << 16); }
__device__ __forceinline__ float bf_hi(unsigned w) { return __uint_as_float(w & 0xffff0000u); }
__device__ __forceinline__ float sigmoid_f(float v) { return __builtin_amdgcn_rcpf(1.0f + __builtin_amdgcn_exp2f(v * -1.4426950408889634f)); }
__device__ __forceinline__ u32x4 pack8(const f32x4 v0, const f32x4 v1) { u32x4 w; w.x = cvt_pk_bf16(v0[0], v0[1]); w.y = cvt_pk_bf16(v0[2], v0[3]); w.z = cvt_pk_bf16(v1[0], v1[1]); w.w = cvt_pk_bf16(v1[2], v1[3]); return w; }

struct EpiStore {
    static constexpr bool PERM = true, AFTER_DRAIN = false;
    bf16_t* O; int ldc;
    __device__ __forceinline__ void operator()(const f32x4 (&acc)[2][2][4][2], const Unit& u, int wr, int wc, int fr, int fq) const {
        const int row0 = u.pm * BM + wr * 64 + fr; const int col0 = u.pn * BM + wc * 32 + 8 * fq;
#pragma unroll
        for (int ai = 0; ai < 2; ++ai)
#pragma unroll
            for (int m = 0; m < 4; ++m) { bf16_t* rowp = O + (size_t)(row0 + ai * HALF + m * 16) * ldc + col0;
#pragma unroll
                for (int bj = 0; bj < 2; ++bj) *(u32x4*)(rowp + bj * HALF) = pack8(acc[ai][bj][m][0], acc[ai][bj][m][1]); }
    }
};
struct EpiSwiglu {
    static constexpr bool PERM = true, AFTER_DRAIN = false;
    bf16_t* O; int ldc;
    __device__ __forceinline__ void operator()(const f32x4 (&acc)[2][2][4][2], const Unit& u, int wr, int wc, int fr, int fq) const {
        const int row0 = u.pm * BM + wr * 64 + fr; const int col0 = u.pn * HALF + wc * 32 + 8 * fq;
#pragma unroll
        for (int ai = 0; ai < 2; ++ai)
#pragma unroll
            for (int m = 0; m < 4; ++m) { bf16_t* rowp = O + (size_t)(row0 + ai * HALF + m * 16) * ldc + col0;
                f32x4 h[2];
#pragma unroll
                for (int n = 0; n < 2; ++n)
#pragma unroll
                    for (int i = 0; i < 4; ++i) { const float g = acc[ai][0][m][n][i], up = acc[ai][1][m][n][i]; h[n][i] = g * sigmoid_f(g) * up; }
                *(u32x4*)rowp = pack8(h[0], h[1]); }
    }
};
struct EpiIn {
    static constexpr bool PERM = true, AFTER_DRAIN = false;
    bf16_t *QA, *KV, *QB, *KB, *VB, *RB, *GA, *GB; float* ALR; float qa_scale, qb_scale;
    __device__ __forceinline__ void operator()(const f32x4 (&acc)[2][2][4][2], const Unit& u, int wr, int wc, int fr, int fq) const {
        const int pn = u.pn; const int row0 = u.pm * BM + wr * 64 + fr;
        if (pn == 17) {
            if (wc == 0 && fq < 2) {
#pragma unroll
                for (int ai = 0; ai < 2; ++ai)
#pragma unroll
                    for (int m = 0; m < 4; ++m) { float* p = ALR + (size_t)(row0 + ai * HALF + m * 16) * 16 + 8 * fq;
                        *(f32x4*)p = acc[ai][0][m][0]; *(f32x4*)(p + 4) = acc[ai][0][m][1]; }
            }
            return;
        }
        bf16_t* base; int ld, colt; float sc = 1.f; int act = 0;
        if (pn < 2) { base = QA; ld = 512; colt = pn * 256; sc = qa_scale; }
        else if (pn == 2) { base = KV; ld = 256; colt = 0; }
        else if (pn == 3) { base = QB; ld = 256; colt = 0; sc = qb_scale; }
        else if (pn == 4) { base = KB; ld = 256; colt = 0; }
        else if (pn < 7) { base = VB; ld = 512; colt = (pn - 5) * 256; }
        else if (pn < 9) { base = RB; ld = 512; colt = (pn - 7) * 256; act = 2; }
        else if (pn < 13) { base = GA; ld = 1024; colt = (pn - 9) * 256; act = 1; }
        else { base = GB; ld = 1024; colt = (pn - 13) * 256; act = 1; }
        const int col0 = colt + wc * 32 + 8 * fq;
#pragma unroll
        for (int ai = 0; ai < 2; ++ai)
#pragma unroll
            for (int m = 0; m < 4; ++m) { bf16_t* rowp = base + (size_t)(row0 + ai * HALF + m * 16) * ld + col0;
#pragma unroll
                for (int bj = 0; bj < 2; ++bj) { f32x4 v0 = acc[ai][bj][m][0] * sc, v1 = acc[ai][bj][m][1] * sc;
                    if (act != 0) {
#pragma unroll
                        for (int i = 0; i < 4; ++i) { const float s0 = sigmoid_f(v0[i]), s1 = sigmoid_f(v1[i]); v0[i] = (act == 1) ? s0 : v0[i] * s0; v1[i] = (act == 1) ? s1 : v1[i] * s1; }
                    }
                    *(u32x4*)(rowp + bj * HALF) = pack8(v0, v1); } }
    }
};
template <bool SECOND> struct EpiGate {
    static constexpr bool PERM = true, AFTER_DRAIN = false;
    const bf16_t* Gt; bf16_t* O;
    __device__ __forceinline__ void operator()(const f32x4 (&acc)[2][2][4][2], const Unit& u, int wr, int wc, int fr, int fq) const {
        const int row0 = u.pm * BM + wr * 64 + fr; const int col0 = u.pn * BM + wc * 32 + 8 * fq;
#pragma unroll
        for (int ai = 0; ai < 2; ++ai)
#pragma unroll
            for (int m = 0; m < 4; ++m) { const size_t off = (size_t)(row0 + ai * HALF + m * 16) * 1024 + col0;
#pragma unroll
                for (int bj = 0; bj < 2; ++bj) { const u32x4 gw = *(const u32x4*)(Gt + off + bj * HALF);
                    f32x4 v0 = acc[ai][bj][m][0], v1 = acc[ai][bj][m][1];
                    v0[0] *= bf_lo(gw.x); v0[1] *= bf_hi(gw.x); v0[2] *= bf_lo(gw.y); v0[3] *= bf_hi(gw.y);
                    v1[0] *= bf_lo(gw.z); v1[1] *= bf_hi(gw.z); v1[2] *= bf_lo(gw.w); v1[3] *= bf_hi(gw.w);
                    if (SECOND) { const u32x4 pw = *(const u32x4*)(O + off + bj * HALF);
                        v0[0] += bf_lo(pw.x); v0[1] += bf_hi(pw.x); v0[2] += bf_lo(pw.y); v0[3] += bf_hi(pw.y);
                        v1[0] += bf_lo(pw.z); v1[1] += bf_hi(pw.z); v1[2] += bf_lo(pw.w); v1[3] += bf_hi(pw.w); }
                    *(u32x4*)(O + off + bj * HALF) = pack8(v0, v1); } }
    }
};
template <class Epi, class Sched, bool ALIGN_EPI = false, bool SP2 = false>
__device__ __forceinline__ void gemm_phase(PG8_LAS unsigned char* lds, const Gemm g, const Sched& S, const Epi& E) {
    const int tid = threadIdx.x, wid = __builtin_amdgcn_readfirstlane(tid >> 6), lane = tid & 63, wr = wid >> 2, wc = wid & 3, fr = lane & 15, fq = lane >> 4;
    const int K = g.K, nt = K / BK;
    unsigned voffA[2], voffB[2];
#pragma unroll
    for (int i = 0; i < 2; ++i) { int R, C; stage_rc(tid * 16 + i * 8192, R, C); const int Rb = Epi::PERM ? ((R & ~31) + perm32(R & 31)) : R;
        voffA[i] = (unsigned)(R * g.lda + C) * 2u; voffB[i] = (unsigned)(Rb * g.ldb + C) * 2u; }
    const size_t kstep = (size_t)(BK * 2);
    const size_t hsA = (size_t)HALF * g.lda * 2, hsB = (size_t)HALF * g.ldb * 2;
    const size_t tsA = 2 * hsA, tsB = 2 * hsB;
    const unsigned ldsw = (unsigned)wid * 1024u;
    const int aoff = lds_byte(wr * 64 + fr, fq * 8), boff = lds_byte(wc * 32 + fr, fq * 8);
#define PG8_SA(b, h) (((b) * 2 + (h)) * HTB)
#define PG8_SB(b, h) ((4 + (b) * 2 + (h)) * HTB)
#define PG8_STAGE(bufoff, gbase, voff) do { _Pragma("unroll") for (int _i = 0; _i < 2; ++_i) \
        __builtin_amdgcn_global_load_lds((const unsigned*)((const char*)(gbase) + (voff)[_i]), (PG8_LAS unsigned*)(lds + (bufoff) + ldsw + _i * 8192), 16, 0, 0); } while (0)
#define PG8_LDA(dst, b, h) do { _Pragma("unroll") for (int m = 0; m < 4; ++m) _Pragma("unroll") for (int k = 0; k < 2; ++k) dst[m][k] = *(const PG8_LAS bf16x8*)(lds + PG8_SA(b, h) + aoff + m * 2048 + k * 1024); } while (0)
#define PG8_LDB(dst, b, h) do { _Pragma("unroll") for (int n = 0; n < 2; ++n) _Pragma("unroll") for (int k = 0; k < 2; ++k) dst[n][k] = *(const PG8_LAS bf16x8*)(lds + PG8_SB(b, h) + boff + n * 2048 + k * 1024); } while (0)
#define PG8_MMA(ai, bj, At, Bt) do { __builtin_amdgcn_s_setprio(1); _Pragma("unroll") for (int m = 0; m < 4; ++m) _Pragma("unroll") for (int n = 0; n < 2; ++n) _Pragma("unroll") for (int k = 0; k < 2; ++k) \
        acc[ai][bj][m][n] = __builtin_amdgcn_mfma_f32_16x16x32_bf16(Bt[n][k], At[m][k], acc[ai][bj][m][n], 0, 0, 0); __builtin_amdgcn_s_setprio(0); } while (0)
#define PG8_WAIT_V(n) asm volatile("s_waitcnt vmcnt(" #n ")" ::: "memory")
#define PG8_WAIT_L(n) asm volatile("s_waitcnt lgkmcnt(" #n ")" ::: "memory")
#define PG8_BAR __builtin_amdgcn_s_barrier()
#define PG8_SCHED __builtin_amdgcn_sched_barrier(0)
    Unit cur, nxt; int ui = 0;
    if (!S.next(0, cur)) return;
    f32x4 acc[2][2][4][2];
#pragma unroll
    for (int a = 0; a < 2; ++a)
#pragma unroll
        for (int b = 0; b < 2; ++b)
#pragma unroll
            for (int m = 0; m < 4; ++m)
#pragma unroll
                for (int n = 0; n < 2; ++n) acc[a][b][m][n] = (f32x4){0.f, 0.f, 0.f, 0.f};
    bf16x8 At[4][2], B0[2][2], B1[2][2];
    const char* cA = (const char*)g.A + (size_t)cur.pm * tsA; const char* cB = (const char*)g.Bt + (size_t)cur.pn * tsB;
    S.a_ready(cur);
    if constexpr (SP2) {
        PG8_STAGE(PG8_SB(0, 0), cB, voffB); PG8_STAGE(PG8_SB(0, 1), cB + hsB, voffB); PG8_STAGE(PG8_SA(0, 0), cA, voffA); PG8_STAGE(PG8_SA(0, 1), cA + hsA, voffA);
        if (wr == 1) PG8_BAR;
        PG8_WAIT_V(2); PG8_BAR;
        PG8_STAGE(PG8_SB(1, 0), cB + kstep, voffB); PG8_STAGE(PG8_SA(1, 0), cA + kstep, voffA); PG8_STAGE(PG8_SB(1, 1), cB + hsB + kstep, voffB);
        PG8_WAIT_V(6); PG8_BAR;
    } else {
        PG8_STAGE(PG8_SB(0, 0), cB, voffB); PG8_STAGE(PG8_SA(0, 0), cA, voffA); PG8_STAGE(PG8_SB(0, 1), cB + hsB, voffB); PG8_STAGE(PG8_SA(0, 1), cA + hsA, voffA);
        if (wr == 1) PG8_BAR;
        PG8_WAIT_V(4); PG8_BAR;
        PG8_STAGE(PG8_SB(1, 0), cB + kstep, voffB); PG8_STAGE(PG8_SA(1, 0), cA + kstep, voffA); PG8_STAGE(PG8_SB(1, 1), cB + hsB + kstep, voffB);
        PG8_WAIT_V(6); PG8_BAR;
    }
    for (;;) {
        const bool has_next = S.next(ui + 1, nxt);
        const char* nA = has_next ? (const char*)g.A + (size_t)nxt.pm * tsA : cA; const char* nB = has_next ? (const char*)g.Bt + (size_t)nxt.pn * tsB : cB;
        for (int t = 0; t < nt; t += 2) {
            const bool last = (t == nt - 2);
            const char* a1 = cA + (size_t)(t + 1) * kstep;
            const char* a2 = last ? nA : cA + (size_t)(t + 2) * kstep; const char* b2 = last ? nB : cB + (size_t)(t + 2) * kstep;
            const char* a3 = a2 + kstep; const char* b3 = b2 + kstep;
            if (last && has_next) S.a_ready(nxt);
            if constexpr (SP2) {
            PG8_LDB(B0, 0, 0); PG8_LDB(B1, 0, 1); PG8_SCHED; PG8_LDA(At, 0, 0); PG8_STAGE(PG8_SA(1, 1), a1 + hsA, voffA);
            PG8_WAIT_V(8); PG8_WAIT_L(0); PG8_BAR; PG8_MMA(0, 0, At, B0); PG8_MMA(0, 1, At, B1); PG8_BAR; PG8_SCHED;
            PG8_LDA(At, 0, 1); PG8_STAGE(PG8_SB(0, 0), b2, voffB); PG8_STAGE(PG8_SB(0, 1), b2 + hsB, voffB); PG8_STAGE(PG8_SA(0, 0), a2, voffA);
            PG8_WAIT_V(8); PG8_WAIT_L(0); PG8_BAR; PG8_MMA(1, 0, At, B0); PG8_MMA(1, 1, At, B1); PG8_BAR; PG8_SCHED;
            PG8_LDB(B0, 1, 0); PG8_LDB(B1, 1, 1); PG8_SCHED; PG8_LDA(At, 1, 0); PG8_STAGE(PG8_SA(0, 1), a2 + hsA, voffA);
            PG8_WAIT_V(8); PG8_WAIT_L(0); PG8_BAR; PG8_MMA(0, 0, At, B0); PG8_MMA(0, 1, At, B1); PG8_BAR; PG8_SCHED;
            PG8_LDA(At, 1, 1); PG8_STAGE(PG8_SB(1, 0), b3, voffB); PG8_STAGE(PG8_SB(1, 1), b3 + hsB, voffB); PG8_STAGE(PG8_SA(1, 0), a3, voffA);
            PG8_WAIT_V(8); PG8_WAIT_L(0); PG8_BAR; PG8_MMA(1, 0, At, B0); PG8_MMA(1, 1, At, B1); PG8_BAR; PG8_SCHED;
            } else {
            PG8_LDB(B0, 0, 0); PG8_SCHED; PG8_LDA(At, 0, 0); PG8_STAGE(PG8_SA(1, 1), a1 + hsA, voffA);
            PG8_WAIT_L(8); PG8_BAR; PG8_WAIT_L(0); PG8_MMA(0, 0, At, B0); PG8_BAR; PG8_SCHED;
            PG8_LDB(B1, 0, 1); PG8_STAGE(PG8_SB(0, 0), b2, voffB);
            PG8_BAR; PG8_WAIT_L(0); PG8_MMA(0, 1, At, B1); PG8_BAR;
            PG8_LDA(At, 0, 1); PG8_STAGE(PG8_SA(0, 0), a2, voffA);
            PG8_BAR; PG8_WAIT_L(0); PG8_MMA(1, 0, At, B0); PG8_BAR; PG8_SCHED;
            PG8_STAGE(PG8_SB(0, 1), b2 + hsB, voffB);
            PG8_WAIT_V(6); PG8_BAR; PG8_MMA(1, 1, At, B1); PG8_BAR;
            PG8_LDB(B0, 1, 0); PG8_SCHED; PG8_LDA(At, 1, 0); PG8_STAGE(PG8_SA(0, 1), a2 + hsA, voffA);
            PG8_WAIT_L(8); PG8_BAR; PG8_WAIT_L(0); PG8_MMA(0, 0, At, B0); PG8_BAR; PG8_SCHED;
            PG8_LDB(B1, 1, 1); PG8_STAGE(PG8_SB(1, 0), b3, voffB);
            PG8_BAR; PG8_WAIT_L(0); PG8_MMA(0, 1, At, B1); PG8_BAR;
            PG8_LDA(At, 1, 1); PG8_STAGE(PG8_SA(1, 0), a3, voffA);
            PG8_BAR; PG8_WAIT_L(0); PG8_MMA(1, 0, At, B0); PG8_BAR; PG8_SCHED;
            PG8_STAGE(PG8_SB(1, 1), b3 + hsB, voffB);
            PG8_WAIT_V(6); PG8_BAR; PG8_MMA(1, 1, At, B1); PG8_BAR;
            }
        }
        if constexpr (ALIGN_EPI) { if (wr == 0) PG8_BAR; }
        if constexpr (!Epi::AFTER_DRAIN) { E(acc, cur, wr, wc, fr, fq); S.done(cur); }
        if (!has_next) break;
#pragma unroll
        for (int a = 0; a < 2; ++a)
#pragma unroll
            for (int b = 0; b < 2; ++b)
#pragma unroll
                for (int m = 0; m < 4; ++m)
#pragma unroll
                    for (int n = 0; n < 2; ++n) acc[a][b][m][n] = (f32x4){0.f, 0.f, 0.f, 0.f};
        cur = nxt; cA = nA; cB = nB; ++ui;
        if constexpr (ALIGN_EPI) { if (wr == 1) PG8_BAR; }
    }
    PG8_WAIT_V(0);
    if constexpr (!ALIGN_EPI) { if (wr == 0) PG8_BAR; }
    PG8_BAR;
    if constexpr (Epi::AFTER_DRAIN) { E.fused(acc, cur, wr, wc, fr, fq, lds, wid, lane); S.done(cur); }
#undef PG8_SA
#undef PG8_SB
#undef PG8_STAGE
#undef PG8_LDA
#undef PG8_LDB
#undef PG8_MMA
#undef PG8_WAIT_V
#undef PG8_WAIT_L
#undef PG8_BAR
#undef PG8_SCHED
}
}

#ifndef FAST_GLA
#define FAST_GLA 1
#endif
constexpr int NWAVES = 8;
#ifndef MK_N_LAUNCHES
#define MK_N_LAUNCHES 1
#endif
constexpr int N_PHASES = 14;
constexpr int N_LAUNCHES = MK_N_LAUNCHES;
static_assert(N_LAUNCHES == 1 || N_LAUNCHES == N_PHASES, "MK_N_LAUNCHES is 1 or N_PHASES");

constexpr int BATCH = 16, SEQ = 2048, D = 1024, FF = 2816;
constexpr int M = BATCH * SEQ;
constexpr int NQH = 8, NKVH = 2, HD = 64, WINDOW = 128;
constexpr int GH = 4, GDK = 64, GDV = 128, GRANK = 16;
constexpr int IN_W = 4368, NIN = 4608;
constexpr float EPS = 1e-6f;
constexpr float LOG2E = 1.4426950408889634f;

constexpr size_t MiB = 1u << 20;
constexpr size_t WS_CTL = 0, CTL_ZERO_BYTES = 1 * MiB;
constexpr size_t WS_W1GU = 2 * MiB, WS_W1D = 13 * MiB, WS_W2GU = 19 * MiB, WS_W2D = 30 * MiB, WS_WIN = 36 * MiB, WS_WPAB = 45 * MiB, WS_WOUT = 47 * MiB;
constexpr size_t WS_HN = 64 * MiB;
constexpr size_t WS_F = 128 * MiB;
constexpr size_t WS_BIG = 192 * MiB;
constexpr size_t WS_QA = WS_BIG, WS_KV = WS_QA + 32 * MiB, WS_QB = WS_KV + 16 * MiB, WS_KB = WS_QB + 16 * MiB, WS_VB = WS_KB + 16 * MiB, WS_RB = WS_VB + 32 * MiB,
                 WS_GA = WS_RB + 32 * MiB, WS_GB = WS_GA + 64 * MiB, WS_ALR = WS_GB + 64 * MiB, WS_ST = WS_ALR + 2 * MiB, WS_DEC = WS_ST + 32 * MiB, WS_END = WS_DEC + 1 * MiB;
constexpr size_t WS_MO = WS_BIG;
static_assert(WS_W1GU + (size_t)2 * FF * D * 2 <= WS_W1D && WS_W1D + (size_t)D * FF * 2 <= WS_W2GU && WS_W2GU + (size_t)2 * FF * D * 2 <= WS_W2D && WS_W2D + (size_t)D * FF * 2 <= WS_WIN &&
              WS_WIN + (size_t)NIN * D * 2 <= WS_WPAB && WS_WPAB + (size_t)D * D * 2 <= WS_WOUT && WS_WOUT + (size_t)D * D * 2 <= WS_HN, "weight map");
static_assert(WS_BIG + (size_t)M * FF * 2 <= 512 * MiB && WS_END <= 512 * MiB, "d_ws map");
constexpr int CW_TMO = 0, CW_CODE = 1;
constexpr int CW_BAR = 4096;

constexpr int RING_OFF = 0, RING_BYTES = 131072;
constexpr int LDSCTL_OFF = RING_BYTES, MISC_OFF = LDSCTL_OFF + 320;
constexpr int LDS_BYTES = 147456;
static_assert(MISC_OFF + 128 <= LDS_BYTES, "LDS map");
#define GAS __attribute__((address_space(1)))
#define LAS __attribute__((address_space(3)))
typedef unsigned short bf16;
typedef unsigned v4u __attribute__((ext_vector_type(4)));
typedef float f32x4 __attribute__((ext_vector_type(4)));
typedef short bf16x8 __attribute__((ext_vector_type(8)));
typedef GAS unsigned gu32;
typedef GAS unsigned long long gu64;
#define RLX_AGENT __ATOMIC_RELAXED, __HIP_MEMORY_SCOPE_AGENT
#define LDS_WAIT() asm volatile("s_waitcnt lgkmcnt(0)" ::: "memory")
#define VM_WAIT() asm volatile("s_waitcnt vmcnt(0)" ::: "memory")
__device__ __forceinline__ unsigned long long rt() { return __builtin_amdgcn_s_memrealtime(); }
__device__ __forceinline__ unsigned f2bf(float f) { unsigned u = __builtin_bit_cast(unsigned, f); return (u + 0x7fffu + ((u >> 16) & 1u)) >> 16; }
__device__ __forceinline__ unsigned pk2(float lo, float hi) { return f2bf(lo) | (f2bf(hi) << 16); }
#define XB_TMO      128
#define XB_XCNT(j)  (256  + 64 * (j))
#define XB_XSUB(j)  (1280 + 64 * (j))
#define XB_XGEN(j)  (2304 + 64 * (j))
#define XB_TOP      3328
#define XB_TOPGEN   3392
#define XCD_BAR_WORDS 3456
#define XB_SPIN_CAP (1u << 18)

__device__ __forceinline__ unsigned xb_ld(unsigned* p)              { return __hip_atomic_load(p, __ATOMIC_RELAXED, __HIP_MEMORY_SCOPE_AGENT); }
__device__ __forceinline__ unsigned xb_add(unsigned* p, unsigned v) { return __hip_atomic_fetch_add(p, v, __ATOMIC_RELAXED, __HIP_MEMORY_SCOPE_AGENT); }
__device__ __forceinline__ unsigned xb_xcc_id() { return (unsigned)__builtin_amdgcn_s_getreg((3 << 11) | 20) & 0xFu; }
#define XB_SPIN(cond, bar) do { unsigned _sp = 0; while (cond) { __builtin_amdgcn_s_sleep(1); \
    if ((++_sp & 255u) == 0u) { if (xb_ld(&(bar)[XB_TMO])) break; if (_sp > XB_SPIN_CAP) { atomicAdd(&(bar)[XB_TMO], 1u); break; } } } } while (0)

struct XcdBarrier {
    unsigned* bar; unsigned x;
    volatile LAS unsigned* st;
};

__device__ __forceinline__ XcdBarrier xcd_barrier_post(unsigned* bar, volatile LAS unsigned* st) {
    XcdBarrier b; b.bar = bar; b.x = xb_xcc_id(); b.st = st;
    if (threadIdx.x == 0) (void)xb_add(&bar[XB_XCNT(b.x)], 1u);
    return b;
}
__device__ __forceinline__ void xcd_barrier_complete(unsigned* bar, unsigned x, unsigned& nloc, unsigned& nx) {
    const unsigned G = gridDim.x * gridDim.y * gridDim.z;
    unsigned sum, cnt, mine, sp = 0u;
    for (;;) {
        sum = 0u; cnt = 0u; mine = 0u;
#pragma unroll
        for (unsigned j = 0; j < 16; ++j) { const unsigned c = xb_ld(&bar[XB_XCNT(j)]); sum += c; cnt += (c > 0u) ? 1u : 0u; mine = (j == x) ? c : mine; }
        if (sum == G) break;
        __builtin_amdgcn_s_sleep(1);
        if ((++sp & 255u) == 0u) { if (xb_ld(&bar[XB_TMO])) break; if (sp > XB_SPIN_CAP) { atomicAdd(&bar[XB_TMO], 1u); break; } }
    }
    nloc = mine > 0u ? mine : 1u; nx = cnt > 0u ? cnt : 1u;
}

__device__ __forceinline__ void xcd_barrier(const XcdBarrier& b) {
    asm volatile("s_waitcnt vmcnt(0)" ::: "memory");
    __syncthreads();
    if (threadIdx.x == 0) {
        unsigned* bar = b.bar;
        __builtin_amdgcn_s_waitcnt(0);
        unsigned nloc = b.st[0], nx = b.st[1];
        if (nloc == 0u) { xcd_barrier_complete(bar, b.x, nloc, nx); b.st[0] = nloc; b.st[1] = nx; }
        const unsigned old = xb_add(&bar[XB_XSUB(b.x)], 1u);
        const unsigned gen = old / nloc;
        if (old + 1u == (gen + 1u) * nloc) {
            __builtin_amdgcn_fence(__ATOMIC_RELEASE, "agent");
            asm volatile("s_waitcnt vmcnt(0)" ::: "memory");
            const unsigned og = xb_add(&bar[XB_TOP], 1u);
            const unsigned tg = og / nx;
            if (og + 1u == (tg + 1u) * nx) xb_add(&bar[XB_TOPGEN], 1u);
            else XB_SPIN(xb_ld(&bar[XB_TOPGEN]) == tg, bar);
            __builtin_amdgcn_fence(__ATOMIC_ACQUIRE, "agent");
            xb_add(&bar[XB_XGEN(b.x)], 1u);
            asm volatile("s_waitcnt vmcnt(0)" ::: "memory");
        } else {
            XB_SPIN(xb_ld(&bar[XB_XGEN(b.x)]) == gen, bar);
            __builtin_amdgcn_fence(__ATOMIC_ACQUIRE, "agent");
            asm volatile("s_waitcnt vmcnt(0)" ::: "memory");
        }
    }
    __syncthreads();
}

struct Frame {
    LAS unsigned char* lds;
    volatile LAS unsigned* MISC;
    gu32* ctl;
    int tid, lane, wave;
    int vcu, G;
    const float* x; float* out;
    const float *rel_bias, *f1_pre_g, *f1_wg, *f1_wu, *f1_wd, *f1_post_g, *mix_pre_g, *w_in, *w_alpha, *b_alpha, *sinks, *gla_g, *w_pa, *w_pb, *w_out, *mix_post_g,
                *f2_pre_g, *f2_wg, *f2_wu, *f2_wd, *f2_post_g;
    bf16 *W1GU, *W1D, *W2GU, *W2D, *WIN, *WPAB, *WOUT;
    bf16 *HN, *FB, *HB, *QA, *KV, *QB, *KB, *VB, *RB, *GA, *GB, *MO;
    float *ALR, *OG;
};

__device__ __forceinline__ float wave_sum(float v) {
#pragma unroll
    for (int o = 1; o < 64; o <<= 1) v += __shfl_xor(v, o);
    return v;
}
__device__ __forceinline__ void p0_transpose_item(const float* W, int ldw, int k0, int n0, int nvalid, bf16* WT, int ldt, int drow0, int kd0, LAS float* scr, int lane) {
#pragma unroll 8
    for (int i = 0; i < 32; ++i) { const int kk = 2 * i + (lane >> 5); const int nn = lane & 31; scr[kk * 33 + nn] = (nn < nvalid) ? W[(size_t)(k0 + kk) * ldw + n0 + nn] : 0.f; }
    LDS_WAIT(); asm volatile("" ::: "memory");
    const int c = lane & 7;
#pragma unroll
    for (int j = 0; j < 4; ++j) { const int n = (lane >> 3) + 8 * j; const LAS float* s = scr + (8 * c) * 33 + n;
        v4u o; o.x = pk2(s[0 * 33], s[1 * 33]); o.y = pk2(s[2 * 33], s[3 * 33]); o.z = pk2(s[4 * 33], s[5 * 33]); o.w = pk2(s[6 * 33], s[7 * 33]);
        *(GAS v4u*)(WT + (size_t)(drow0 + n) * ldt + kd0 + 8 * c) = o; }
    LDS_WAIT(); asm volatile("" ::: "memory");
}
__device__ __forceinline__ void p0_item_gu(const float* Wg, const float* Wu, bf16* WT, int r, LAS float* scr, int lane) {
    constexpr int NB = FF / 32;
    const int which = r / (16 * NB); r -= which * 16 * NB; const int kb = r / NB, nb = r % NB, n0 = 32 * nb;
    const int drow = 256 * (n0 / 128) + (n0 % 128) + which * 128;
    p0_transpose_item(which ? Wu : Wg, FF, 64 * kb, n0, 32, WT, D, drow, 64 * kb, scr, lane);
}
__device__ __forceinline__ void p0_item_down(const float* Wd, bf16* WT, int r, LAS float* scr, int lane) {
    const int kb = r / 32, nb = r % 32;
    p0_transpose_item(Wd, D, 64 * kb, 32 * nb, 32, WT, FF, 32 * nb, 64 * kb, scr, lane);
}
__device__ __forceinline__ void p0_prologue(Frame& F) {
    LAS float* scr = (LAS float*)(F.lds + RING_OFF + F.wave * 16384);
    const int gw = F.vcu * NWAVES + F.wave, NGW = F.G * NWAVES;
    constexpr int I_GU = 2 * 16 * (FF / 32), I_DN = (FF / 64) * (D / 32), I_IN = 16 * 137, I_P = 8 * 32, I_O = 16 * 32;
    constexpr int NITEMS = 2 * I_GU + 2 * I_DN + I_IN + 2 * I_P + I_O;
    for (int it = gw; it < NITEMS; it += NGW) {
        int r = it;
        if (r < I_GU) { p0_item_gu(F.f1_wg, F.f1_wu, F.W1GU, r, scr, F.lane); continue; } r -= I_GU;
        if (r < I_GU) { p0_item_gu(F.f2_wg, F.f2_wu, F.W2GU, r, scr, F.lane); continue; } r -= I_GU;
        if (r < I_DN) { p0_item_down(F.f1_wd, F.W1D, r, scr, F.lane); continue; } r -= I_DN;
        if (r < I_DN) { p0_item_down(F.f2_wd, F.W2D, r, scr, F.lane); continue; } r -= I_DN;
        if (r < I_IN) {
            const int kb = r / 137, nb = r % 137;
            if (nb < 136) { const int drow = 32 * nb; const int scol = drow < 2304 ? drow : drow + 16; p0_transpose_item(F.w_in, IN_W, 64 * kb, scol, 32, F.WIN, D, drow, 64 * kb, scr, F.lane); }
            else p0_transpose_item(F.w_in, IN_W, 64 * kb, 2304, 16, F.WIN, D, 4352, 64 * kb, scr, F.lane);
            continue; } r -= I_IN;
        if (r < I_P) { const int kb = r / 32, nb = r % 32; p0_transpose_item(F.w_pa, D, 64 * kb, 32 * nb, 32, F.WPAB, D, 32 * nb, 64 * kb, scr, F.lane); continue; } r -= I_P;
        if (r < I_P) { const int kb = r / 32, nb = r % 32; p0_transpose_item(F.w_pb, D, 64 * kb, 32 * nb, 32, F.WPAB, D, 32 * nb, 512 + 64 * kb, scr, F.lane); continue; } r -= I_P;
        { const int kb = r / 32, nb = r % 32; p0_transpose_item(F.w_out, D, 64 * kb, 32 * nb, 32, F.WOUT, D, 32 * nb, 64 * kb, scr, F.lane); }
    }
    for (int rr = gw; rr < 224; rr += NGW) { GAS v4u* o = (GAS v4u*)(F.WIN + (size_t)(4384 + rr) * D) + F.lane; o[0] = (v4u){0u, 0u, 0u, 0u}; o[64] = (v4u){0u, 0u, 0u, 0u}; }
    {
        f32x4 g[4];
#pragma unroll
        for (int j = 0; j < 4; ++j) g[j] = ((const GAS f32x4*)F.f1_pre_g)[F.lane + 64 * j];
        for (int m = gw; m < M; m += NGW) {
            const GAS f32x4* xr = (const GAS f32x4*)(F.x + (size_t)m * D) + F.lane;
            f32x4 v[4]; float s = 0.f;
#pragma unroll
            for (int j = 0; j < 4; ++j) { v[j] = xr[64 * j]; s += (v[j].x * v[j].x + v[j].y * v[j].y) + (v[j].z * v[j].z + v[j].w * v[j].w); }
            const float rs = 1.f / sqrtf(wave_sum(s) * (1.f / D) + EPS);
            GAS unsigned long long* o8 = (GAS unsigned long long*)(F.HN + (size_t)m * D) + F.lane;
#pragma unroll
            for (int j = 0; j < 4; ++j) { const f32x4 y = v[j] * rs * g[j]; o8[64 * j] = (unsigned long long)pk2(y.x, y.y) | ((unsigned long long)pk2(y.z, y.w) << 32); }
        }
    }
}
template <bool HAS_HN> __device__ __forceinline__ void thin_norm(Frame& F, const bf16* fin, const float* xi, float* xo, float coef, const float* gpost, bf16* hn, const float* gpre) {
    const int gw = F.vcu * NWAVES + F.wave, NGW = F.G * NWAVES;
    f32x4 gp[4], gq[4];
#pragma unroll
    for (int j = 0; j < 4; ++j) { gp[j] = ((const GAS f32x4*)gpost)[F.lane + 64 * j] * coef; if (HAS_HN) gq[j] = ((const GAS f32x4*)gpre)[F.lane + 64 * j]; }
    for (int m = gw; m < M; m += NGW) {
        const GAS unsigned long long* fr = (const GAS unsigned long long*)(fin + (size_t)m * D) + F.lane;
        const GAS f32x4* xr = (const GAS f32x4*)(xi + (size_t)m * D) + F.lane;
        f32x4 f[4], xv[4]; float s = 0.f;
#pragma unroll
        for (int j = 0; j < 4; ++j) { const unsigned long long w = fr[64 * j]; const unsigned lo = (unsigned)w, hi = (unsigned)(w >> 32);
            f[j] = (f32x4){pg8::bf_lo(lo), pg8::bf_hi(lo), pg8::bf_lo(hi), pg8::bf_hi(hi)}; xv[j] = xr[64 * j];
            s += (f[j].x * f[j].x + f[j].y * f[j].y) + (f[j].z * f[j].z + f[j].w * f[j].w); }
        const float rs = 1.f / sqrtf(wave_sum(s) * (1.f / D) + EPS);
        float s2 = 0.f;
        GAS f32x4* xw = (GAS f32x4*)(xo + (size_t)m * D) + F.lane;
#pragma unroll
        for (int j = 0; j < 4; ++j) { xv[j] = xv[j] + f[j] * rs * gp[j]; xw[64 * j] = xv[j]; s2 += (xv[j].x * xv[j].x + xv[j].y * xv[j].y) + (xv[j].z * xv[j].z + xv[j].w * xv[j].w); }
        if (HAS_HN) {
            const float rs2 = 1.f / sqrtf(wave_sum(s2) * (1.f / D) + EPS);
            GAS unsigned long long* o8 = (GAS unsigned long long*)(hn + (size_t)m * D) + F.lane;
#pragma unroll
            for (int j = 0; j < 4; ++j) { const f32x4 y = xv[j] * rs2 * gq[j]; o8[64 * j] = (unsigned long long)pk2(y.x, y.y) | ((unsigned long long)pk2(y.z, y.w) << 32); }
        }
    }
}

__device__ __forceinline__ int t5_bucket(int d) {
    if (d < 16) return d;
    return 16 + (d >= 19) + (d >= 21) + (d >= 24) + (d >= 27) + (d >= 31) + (d >= 35) + (d >= 40) + (d >= 46) + (d >= 52) + (d >= 59) + (d >= 67) + (d >= 77) + (d >= 87) + (d >= 99) + (d >= 113);
}
__device__ __forceinline__ void gla_naive(Frame& F) {
    LAS float* L = (LAS float*)(F.lds + RING_OFF);
    LAS float* qs = L;
    LAS float* ks = L + 4096;
    LAS float* adec = L + 8192;
    LAS float* vs = L + 12288;
    LAS float* os = L + 14336;
    for (int u = blockIdx.x; u < BATCH * GH * 4; u += F.G) {
        const int b = u / 16, h = (u / 4) % 4, e0 = (u % 4) * 32;
        float S[32];
#pragma unroll
        for (int i = 0; i < 32; ++i) S[i] = 0.f;
        for (int c = 0; c < SEQ / 64; ++c) {
            const int tok0 = b * SEQ + c * 64;
            {
                const int tt = F.tid >> 3, d0 = (F.tid & 7) * 8; const size_t tok = (size_t)tok0 + tt;
                const v4u qw = *(const GAS v4u*)(F.QB + tok * 256 + h * 64 + d0), kw = *(const GAS v4u*)(F.KB + tok * 256 + h * 64 + d0);
                LAS float* qd = qs + tt * 64 + d0; LAS float* kd = ks + tt * 64 + d0;
                qd[0] = pg8::bf_lo(qw.x); qd[1] = pg8::bf_hi(qw.x); qd[2] = pg8::bf_lo(qw.y); qd[3] = pg8::bf_hi(qw.y); qd[4] = pg8::bf_lo(qw.z); qd[5] = pg8::bf_hi(qw.z); qd[6] = pg8::bf_lo(qw.w); qd[7] = pg8::bf_hi(qw.w);
                kd[0] = pg8::bf_lo(kw.x); kd[1] = pg8::bf_hi(kw.x); kd[2] = pg8::bf_lo(kw.y); kd[3] = pg8::bf_hi(kw.y); kd[4] = pg8::bf_lo(kw.z); kd[5] = pg8::bf_hi(kw.z); kd[6] = pg8::bf_lo(kw.w); kd[7] = pg8::bf_hi(kw.w);
                float z[8];
#pragma unroll
                for (int i = 0; i < 8; ++i) z[i] = F.b_alpha[h * 64 + d0 + i];
#pragma unroll
                for (int r = 0; r < GRANK; ++r) { const float a = F.ALR[tok * 16 + r];
#pragma unroll
                    for (int i = 0; i < 8; ++i) z[i] += a * F.w_alpha[r * 256 + h * 64 + d0 + i]; }
#pragma unroll
                for (int i = 0; i < 8; ++i) { const float ls = fminf(z[i], 0.f) - log1pf(expf(-fabsf(z[i]))); adec[tt * 64 + d0 + i] = expf(ls * (1.f / 16.f)); }
                const int vt = F.tid >> 3, ve = (F.tid & 7) * 4;
                const unsigned long long vw = *(const GAS unsigned long long*)(F.VB + ((size_t)tok0 + vt) * 512 + h * 128 + e0 + ve);
                const unsigned vlo = (unsigned)vw, vhi = (unsigned)(vw >> 32);
                LAS float* vd = vs + vt * 32 + ve; vd[0] = pg8::bf_lo(vlo); vd[1] = pg8::bf_hi(vlo); vd[2] = pg8::bf_lo(vhi); vd[3] = pg8::bf_hi(vhi);
            }
            __syncthreads();
            if (F.wave == 0) {
                const int e = F.lane & 31, hf = F.lane >> 5;
                for (int t = 0; t < 64; ++t) {
                    const float v = vs[t * 32 + e]; float acc = 0.f;
                    const LAS float* ap = adec + t * 64 + hf * 32; const LAS float* kp = ks + t * 64 + hf * 32; const LAS float* qp = qs + t * 64 + hf * 32;
#pragma unroll
                    for (int dd = 0; dd < 32; ++dd) { S[dd] = ap[dd] * S[dd] + kp[dd] * v; acc += qp[dd] * S[dd]; }
                    acc += __shfl_xor(acc, 32);
                    if (hf == 0) os[t * 32 + e] = acc;
                }
            }
            __syncthreads();
            { const int vt = F.tid >> 3, ve = (F.tid & 7) * 4; const LAS float* od = os + vt * 32 + ve;
              *(GAS f32x4*)(F.OG + ((size_t)tok0 + vt) * 512 + h * 128 + e0 + ve) = (f32x4){od[0], od[1], od[2], od[3]}; }
        }
    }
}
__device__ __forceinline__ void attn_naive(Frame& F) {
    LAS float* btab = (LAS float*)(F.lds + RING_OFF) + 16384;
    __syncthreads();
    for (int i = F.tid; i < NQH * 128; i += NWAVES * 64) { const int h = i >> 7, d = i & 127; btab[i] = F.rel_bias[t5_bucket(d) * NQH + h] * LOG2E; }
    __syncthreads();
    for (int item = blockIdx.x * (NWAVES * 64) + F.tid; item < M * NQH; item += F.G * NWAVES * 64) {
        const int h = item / M, tok = item % M, p = tok % SEQ, kvh = h / (NQH / NKVH);
        float q[64], o[64];
        { const GAS v4u* qp = (const GAS v4u*)(F.QA + (size_t)tok * 512 + h * 64);
#pragma unroll
          for (int j = 0; j < 8; ++j) { const v4u w = qp[j]; q[8 * j + 0] = pg8::bf_lo(w.x); q[8 * j + 1] = pg8::bf_hi(w.x); q[8 * j + 2] = pg8::bf_lo(w.y); q[8 * j + 3] = pg8::bf_hi(w.y);
              q[8 * j + 4] = pg8::bf_lo(w.z); q[8 * j + 5] = pg8::bf_hi(w.z); q[8 * j + 6] = pg8::bf_lo(w.w); q[8 * j + 7] = pg8::bf_hi(w.w); } }
#pragma unroll
        for (int j = 0; j < 64; ++j) o[j] = 0.f;
        float mrun = F.sinks[h] * LOG2E, l = 1.f;
        const int nd = p < WINDOW - 1 ? p : WINDOW - 1;
        for (int d = 0; d <= nd; ++d) {
            const GAS v4u* kp = (const GAS v4u*)(F.KV + (size_t)(tok - d) * 256 + kvh * 64);
            float s = 0.f;
#pragma unroll
            for (int j = 0; j < 8; ++j) { const v4u w = kp[j];
                s += q[8 * j + 0] * pg8::bf_lo(w.x) + q[8 * j + 1] * pg8::bf_hi(w.x) + q[8 * j + 2] * pg8::bf_lo(w.y) + q[8 * j + 3] * pg8::bf_hi(w.y)
                   + q[8 * j + 4] * pg8::bf_lo(w.z) + q[8 * j + 5] * pg8::bf_hi(w.z) + q[8 * j + 6] * pg8::bf_lo(w.w) + q[8 * j + 7] * pg8::bf_hi(w.w); }
            s += btab[h * 128 + d];
            const float mn = fmaxf(mrun, s), al = exp2f(mrun - mn), pe = exp2f(s - mn);
            l = l * al + pe; mrun = mn;
            const GAS v4u* vp = (const GAS v4u*)(F.KV + (size_t)(tok - d) * 256 + 128 + kvh * 64);
#pragma unroll
            for (int j = 0; j < 8; ++j) { const v4u w = vp[j];
                o[8 * j + 0] = o[8 * j + 0] * al + pe * pg8::bf_lo(w.x); o[8 * j + 1] = o[8 * j + 1] * al + pe * pg8::bf_hi(w.x);
                o[8 * j + 2] = o[8 * j + 2] * al + pe * pg8::bf_lo(w.y); o[8 * j + 3] = o[8 * j + 3] * al + pe * pg8::bf_hi(w.y);
                o[8 * j + 4] = o[8 * j + 4] * al + pe * pg8::bf_lo(w.z); o[8 * j + 5] = o[8 * j + 5] * al + pe * pg8::bf_hi(w.z);
                o[8 * j + 6] = o[8 * j + 6] * al + pe * pg8::bf_lo(w.w); o[8 * j + 7] = o[8 * j + 7] * al + pe * pg8::bf_hi(w.w); }
        }
        const float il = 1.f / l;
        GAS v4u* yp = (GAS v4u*)(F.HN + (size_t)tok * D + h * 64);
#pragma unroll
        for (int j = 0; j < 8; ++j) { v4u w; w.x = pk2(o[8 * j + 0] * il, o[8 * j + 1] * il); w.y = pk2(o[8 * j + 2] * il, o[8 * j + 3] * il); w.z = pk2(o[8 * j + 4] * il, o[8 * j + 5] * il); w.w = pk2(o[8 * j + 6] * il, o[8 * j + 7] * il); yp[j] = w; }
    }
}
__device__ __forceinline__ void gla_post(Frame& F) {
    const int gw = F.vcu * NWAVES + F.wave, NGW = F.G * NWAVES;
    const int e = (F.lane & 15) * 8;
    const f32x4 g0 = *(const GAS f32x4*)(F.gla_g + e), g1 = *(const GAS f32x4*)(F.gla_g + e + 4);
    for (int m = gw; m < M; m += NGW) {
        const GAS f32x4* op = (const GAS f32x4*)(F.OG + (size_t)m * 512 + F.lane * 8);
        const f32x4 a = op[0], b = op[1];
        float s = (a.x * a.x + a.y * a.y) + (a.z * a.z + a.w * a.w) + (b.x * b.x + b.y * b.y) + (b.z * b.z + b.w * b.w);
        s += __shfl_xor(s, 1); s += __shfl_xor(s, 2); s += __shfl_xor(s, 4); s += __shfl_xor(s, 8);
        const float rs = 1.f / sqrtf(s * (1.f / GDV) + EPS);
        const v4u rw = *(const GAS v4u*)(F.RB + (size_t)m * 512 + F.lane * 8);
        const f32x4 ya = a * rs * g0, yb = b * rs * g1;
        v4u w; w.x = pk2(ya.x * pg8::bf_lo(rw.x), ya.y * pg8::bf_hi(rw.x)); w.y = pk2(ya.z * pg8::bf_lo(rw.y), ya.w * pg8::bf_hi(rw.y));
        w.z = pk2(yb.x * pg8::bf_lo(rw.z), yb.y * pg8::bf_hi(rw.z)); w.w = pk2(yb.z * pg8::bf_lo(rw.w), yb.w * pg8::bf_hi(rw.w));
        *(GAS v4u*)(F.HN + (size_t)m * D + 512 + F.lane * 8) = w;
    }
}


namespace mix {
typedef short bf16x8 __attribute__((ext_vector_type(8)));
typedef short s16x4 __attribute__((ext_vector_type(4)));
typedef float f32x16 __attribute__((ext_vector_type(16)));
typedef float f32x2_t __attribute__((ext_vector_type(2)));
typedef __bf16 bf16x2_t __attribute__((ext_vector_type(2)));
#define MIX_DI __device__ __forceinline__
#define MFMA32(a, b, c) __builtin_amdgcn_mfma_f32_32x32x16_bf16((a), (b), (c), 0, 0, 0)
MIX_DI unsigned cvtpk(float lo, float hi) { f32x2_t v = {lo, hi}; bf16x2_t b = __builtin_convertvector(v, bf16x2_t); return __builtin_bit_cast(unsigned, b); }
MIX_DI int crow(int r, int hi) { return (r & 3) + 8 * (r >> 2) + 4 * hi; }
template <int S8> MIX_DI bf16x8 pack8(const f32x16& x) {
    v4u p; p.x = cvtpk(x[8 * S8 + 0], x[8 * S8 + 1]); p.y = cvtpk(x[8 * S8 + 2], x[8 * S8 + 3]); p.z = cvtpk(x[8 * S8 + 4], x[8 * S8 + 5]); p.w = cvtpk(x[8 * S8 + 6], x[8 * S8 + 7]);
    return __builtin_bit_cast(bf16x8, p);
}
MIX_DI bf16x8 join8(const s16x4 lo, const s16x4 hi) { return __builtin_shufflevector(lo, hi, 0, 1, 2, 3, 4, 5, 6, 7); }
MIX_DI float ex2(float x) { return __builtin_amdgcn_exp2f(x); }

constexpr int ATT_KT = 0, ATT_KP = 144;
constexpr int ATT_VT = 27648, ATT_VP = 392;
constexpr int ATT_BT = 53248;
constexpr int ATT_END = ATT_BT + 8 * 192 * 4;
MIX_DI void attn_bias_table(Frame& F) {
    LAS float* BT = (LAS float*)(F.lds + RING_OFF + ATT_BT);
    for (int i = F.tid; i < NQH * 192; i += NWAVES * 64) { const int h = i / 192, dist = i % 192 - 32;
        BT[i] = (dist >= 0 && dist < WINDOW) ? F.rel_bias[t5_bucket(dist) * NQH + h] * LOG2E : -__builtin_inff(); }
}
MIX_DI void attn_unit(Frame& F, int b, int kvh, int qt) {
    LAS unsigned char* KT = F.lds + RING_OFF + ATT_KT; LAS unsigned char* VT = F.lds + RING_OFF + ATT_VT; const LAS float* BT = (const LAS float*)(F.lds + RING_OFF + ATT_BT);
    const int p0 = qt * 64, kt0 = p0 - 128; const size_t rowbase = (size_t)b * SEQ;
#pragma unroll
    for (int i = 0; i < 3; ++i) { const int c = F.tid + 512 * i, row = c >> 3, ch = c & 7, kp = kt0 + row;
        v4u kw = (v4u){0u, 0u, 0u, 0u}, vw = (v4u){0u, 0u, 0u, 0u};
        if (kp >= 0) { const bf16* src = F.KV + (rowbase + kp) * 256 + kvh * 64 + ch * 8; kw = *(const GAS v4u*)src; vw = *(const GAS v4u*)(src + 128); }
        *(LAS v4u*)(KT + row * ATT_KP + ch * 16) = kw;
        LAS unsigned short* vt = (LAS unsigned short*)(VT + (ch * 8) * ATT_VP) + row;
        vt[0 * (ATT_VP / 2)] = (unsigned short)(vw.x & 0xffffu); vt[1 * (ATT_VP / 2)] = (unsigned short)(vw.x >> 16);
        vt[2 * (ATT_VP / 2)] = (unsigned short)(vw.y & 0xffffu); vt[3 * (ATT_VP / 2)] = (unsigned short)(vw.y >> 16);
        vt[4 * (ATT_VP / 2)] = (unsigned short)(vw.z & 0xffffu); vt[5 * (ATT_VP / 2)] = (unsigned short)(vw.z >> 16);
        vt[6 * (ATT_VP / 2)] = (unsigned short)(vw.w & 0xffffu); vt[7 * (ATT_VP / 2)] = (unsigned short)(vw.w >> 16); }
    const int g = F.wave >> 1, half = F.wave & 1, hq = kvh * (NQH / NKVH) + g, jl = F.lane & 31, hh = F.lane >> 5;
    const size_t qrow = rowbase + p0 + 32 * half + jl;
    bf16x8 qf[4];
    { const bf16* qp = F.QA + qrow * 512 + hq * 64 + 8 * hh;
#pragma unroll
      for (int ks = 0; ks < 4; ++ks) qf[ks] = *(const GAS bf16x8*)(qp + 16 * ks); }
    __syncthreads();
    f32x16 S[5];
#pragma unroll
    for (int bi = 0; bi < 5; ++bi) { const int blk = half + bi;
#pragma unroll
        for (int r = 0; r < 16; ++r) { const int i = crow(r, hh); float c = BT[hq * 192 + 160 - 32 * bi + jl - i]; if (kt0 < 0 && kt0 + 32 * blk + i < 0) c = -__builtin_inff(); S[bi][r] = c; }
#pragma unroll
        for (int ks = 0; ks < 4; ++ks) { const bf16x8 kf = *(const LAS bf16x8*)(KT + (32 * blk + jl) * ATT_KP + (2 * ks + hh) * 16); S[bi] = MFMA32(kf, qf[ks], S[bi]); } }
    const float sk = F.sinks[hq] * LOG2E;
    float m = sk;
#pragma unroll
    for (int bi = 0; bi < 5; ++bi)
#pragma unroll
        for (int r = 0; r < 16; ++r) m = fmaxf(m, S[bi][r]);
    m = fmaxf(m, __shfl_xor(m, 32));
    float l = 0.f;
#pragma unroll
    for (int bi = 0; bi < 5; ++bi)
#pragma unroll
        for (int r = 0; r < 16; ++r) { const float p = ex2(S[bi][r] - m); S[bi][r] = p; l += p; }
    l += __shfl_xor(l, 32); l += ex2(sk - m);
    f32x16 O0, O1;
#pragma unroll
    for (int r = 0; r < 16; ++r) { O0[r] = 0.f; O1[r] = 0.f; }
#define ATT_PV(bi, s2) do { const bf16x8 pb = pack8<s2>(S[bi]); const int ko = (32 * (half + bi) + 16 * s2 + 4 * hh) * 2; \
        const LAS unsigned char* v0 = VT + jl * ATT_VP + ko; const LAS unsigned char* v1 = VT + (32 + jl) * ATT_VP + ko; \
        O0 = MFMA32(join8(*(const LAS s16x4*)v0, *(const LAS s16x4*)(v0 + 16)), pb, O0); O1 = MFMA32(join8(*(const LAS s16x4*)v1, *(const LAS s16x4*)(v1 + 16)), pb, O1); } while (0)
    ATT_PV(0, 0); ATT_PV(0, 1); ATT_PV(1, 0); ATT_PV(1, 1); ATT_PV(2, 0); ATT_PV(2, 1); ATT_PV(3, 0); ATT_PV(3, 1); ATT_PV(4, 0); ATT_PV(4, 1);
#undef ATT_PV
    const float il = 1.f / l;
    bf16* yp = F.HN + qrow * D + hq * 64 + 4 * hh;
#pragma unroll
    for (int gq = 0; gq < 4; ++gq) {
        *(GAS unsigned long long*)(yp + 8 * gq) = (unsigned long long)cvtpk(O0[4 * gq] * il, O0[4 * gq + 1] * il) | ((unsigned long long)cvtpk(O0[4 * gq + 2] * il, O0[4 * gq + 3] * il) << 32);
        *(GAS unsigned long long*)(yp + 32 + 8 * gq) = (unsigned long long)cvtpk(O1[4 * gq] * il, O1[4 * gq + 1] * il) | ((unsigned long long)cvtpk(O1[4 * gq + 2] * il, O1[4 * gq + 3] * il) << 32); }
    __syncthreads();
}
}


namespace mix {
constexpr int GL_P = 144;
constexpr int GL_QD = 0, GL_KI = 9216, GL_KST = 18432, GL_VT = 27648;
constexpr int GL_TOT = 46080, GL_DEC = 48128, GL_SSX = 48384, GL_END = 49408;
constexpr int GLA_UNITS = BATCH * GH * (SEQ / 64);
MIX_DI unsigned short bf1(float x) { return (unsigned short)(cvtpk(x, x) & 0xffffu); }
MIX_DI float logsig(float z) { return fminf(z, 0.f) - __builtin_amdgcn_logf(1.f + ex2(-fabsf(z) * LOG2E)) * 0.6931471805599453f; }
MIX_DI size_t vt_off(size_t tok0, int h, int e, int ch) { return ((tok0 + (e >> 1)) * 512 + h * 128 + (e & 1) * 64 + ch * 8) * 2; }

MIX_DI void gla_pass_a(Frame& F, int u, float* dST, float* DECg) {
    LAS unsigned char* L = F.lds + RING_OFF;
    LAS unsigned char* QD = L + GL_QD; LAS unsigned char* KI = L + GL_KI; LAS unsigned char* KST = L + GL_KST; LAS unsigned char* VT = L + GL_VT;
    LAS float* TOT = (LAS float*)(L + GL_TOT);
    const int b = u / (GH * (SEQ / 64)), h = (u / (SEQ / 64)) % GH, c = u % (SEQ / 64);
    const int w = F.wave, d = F.lane, jl = F.lane & 31, hh = F.lane >> 5;
    const size_t tok0 = (size_t)b * SEQ + c * 64;
    float wa[16];
#pragma unroll
    for (int r = 0; r < GRANK; ++r) wa[r] = F.w_alpha[r * 256 + h * 64 + d];
    const float ba = F.b_alpha[h * 64 + d];
    float pb[8]; unsigned short qraw[8], kraw[8]; float run = 0.f;
#pragma unroll
    for (int i = 0; i < 8; ++i) { const size_t tok = tok0 + 8 * w + i; const float* ar = F.ALR + tok * 16; float z = ba;
#pragma unroll
        for (int r = 0; r < GRANK; ++r) z += ar[r] * wa[r];
        run += logsig(z) * (1.f / 16.f); pb[i] = run;
        qraw[i] = *(const GAS unsigned short*)(F.QB + tok * 256 + h * 64 + d); kraw[i] = *(const GAS unsigned short*)(F.KB + tok * 256 + h * 64 + d); }
    TOT[w * 64 + d] = run;
    v4u vw[2];
#pragma unroll
    for (int i = 0; i < 2; ++i) { const int cidx = F.tid + 512 * i; vw[i] = *(const GAS v4u*)(F.VB + (tok0 + (cidx >> 4)) * 512 + h * 128 + (cidx & 15) * 8); }
    __syncthreads();
    float off = 0.f, tot = 0.f;
#pragma unroll
    for (int ww = 0; ww < 8; ++ww) { const float x = TOT[ww * 64 + d]; tot += x; off += (ww < w) ? x : 0.f; }
    { v4u kst; unsigned short ksv[8];
#pragma unroll
      for (int i = 0; i < 8; ++i) { const float bb = off + pb[i]; const float q = __uint_as_float((unsigned)qraw[i] << 16), k = __uint_as_float((unsigned)kraw[i] << 16);
          const float eb_ = ex2(bb * LOG2E), en = ex2(-bb * LOG2E), es = ex2((tot - bb) * LOG2E);
          *(LAS unsigned short*)(QD + (8 * w + i) * GL_P + d * 2) = bf1(q * eb_);
          *(LAS unsigned short*)(KI + (8 * w + i) * GL_P + d * 2) = bf1(k * en);
          ksv[i] = bf1(k * es); }
      kst.x = (unsigned)ksv[0] | ((unsigned)ksv[1] << 16); kst.y = (unsigned)ksv[2] | ((unsigned)ksv[3] << 16); kst.z = (unsigned)ksv[4] | ((unsigned)ksv[5] << 16); kst.w = (unsigned)ksv[6] | ((unsigned)ksv[7] << 16);
      *(LAS v4u*)(KST + d * GL_P + w * 16) = kst; }
    if (w == 0) DECg[(size_t)u * 64 + d] = ex2(tot * LOG2E);
#pragma unroll
    for (int i = 0; i < 2; ++i) { const int cidx = F.tid + 512 * i, t = cidx >> 4, ec = cidx & 15;
        LAS unsigned short* vt = (LAS unsigned short*)(VT + (ec * 8) * GL_P) + t;
        vt[0 * (GL_P / 2)] = (unsigned short)(vw[i].x & 0xffffu); vt[1 * (GL_P / 2)] = (unsigned short)(vw[i].x >> 16);
        vt[2 * (GL_P / 2)] = (unsigned short)(vw[i].y & 0xffffu); vt[3 * (GL_P / 2)] = (unsigned short)(vw[i].y >> 16);
        vt[4 * (GL_P / 2)] = (unsigned short)(vw[i].z & 0xffffu); vt[5 * (GL_P / 2)] = (unsigned short)(vw[i].z >> 16);
        vt[6 * (GL_P / 2)] = (unsigned short)(vw[i].w & 0xffffu); vt[7 * (GL_P / 2)] = (unsigned short)(vw[i].w >> 16); }
    __syncthreads();
    { const int db = w & 1, eb = w >> 1;
      f32x16 Sd;
#pragma unroll
      for (int r = 0; r < 16; ++r) Sd[r] = 0.f;
#pragma unroll
      for (int ks = 0; ks < 4; ++ks) Sd = MFMA32(*(const LAS bf16x8*)(KST + (32 * db + jl) * GL_P + (2 * ks + hh) * 16), *(const LAS bf16x8*)(VT + (32 * eb + jl) * GL_P + (2 * ks + hh) * 16), Sd);
      float* dp = dST + ((size_t)u * 128 + 32 * eb + jl) * 64 + 32 * db + 4 * hh;
#pragma unroll
      for (int gq = 0; gq < 4; ++gq) *(GAS f32x4*)(dp + 8 * gq) = (f32x4){Sd[4 * gq], Sd[4 * gq + 1], Sd[4 * gq + 2], Sd[4 * gq + 3]}; }
    { const int t = F.tid >> 3, ch = F.tid & 7;
      *(GAS v4u*)(F.QB + (tok0 + t) * 256 + h * 64 + ch * 8) = *(const LAS v4u*)(QD + t * GL_P + ch * 16);
      *(GAS v4u*)(F.KB + (tok0 + t) * 256 + h * 64 + ch * 8) = *(const LAS v4u*)(KI + t * GL_P + ch * 16);
#pragma unroll
      for (int i = 0; i < 2; ++i) { const int cidx = F.tid + 512 * i, e = cidx >> 3, ch2 = cidx & 7;
          *(GAS v4u*)((unsigned char*)F.VB + vt_off(tok0, h, e, ch2)) = *(const LAS v4u*)(VT + e * GL_P + ch2 * 16); } }
    __syncthreads();
}

MIX_DI void gla_scan(Frame& F, const float* dST, const float* DECg, bf16* ST) {
    const int nthreads = F.G * NWAVES * 64;
    for (int gt = blockIdx.x * (NWAVES * 64) + F.tid; gt < BATCH * GH * 128 * 16; gt += nthreads) {
        const int bh = gt >> 11, e = (gt >> 4) & 127, dg = gt & 15;
        f32x4 S = (f32x4){0.f, 0.f, 0.f, 0.f};
        const size_t u0 = (size_t)bh * (SEQ / 64);
#pragma unroll 1
        for (int c0 = 0; c0 < SEQ / 64; c0 += 8) {
            f32x4 ds[8], dc[8];
#pragma unroll
            for (int i = 0; i < 8; ++i) { ds[i] = *(const GAS f32x4*)(dST + ((u0 + c0 + i) * 128 + e) * 64 + 4 * dg); dc[i] = *(const GAS f32x4*)(DECg + (u0 + c0 + i) * 64 + 4 * dg); }
#pragma unroll
            for (int i = 0; i < 8; ++i) {
                *(GAS unsigned long long*)(ST + ((u0 + c0 + i) * 128 + e) * 64 + 4 * dg) = (unsigned long long)cvtpk(S.x, S.y) | ((unsigned long long)cvtpk(S.z, S.w) << 32);
                S = S * dc[i] + ds[i]; }
        }
    }
}

MIX_DI void gla_pass_c(Frame& F, int u, const bf16* ST) {
    LAS unsigned char* L = F.lds + RING_OFF;
    LAS unsigned char* QD = L + GL_QD; LAS unsigned char* KI = L + GL_KI; LAS unsigned char* VT = L + GL_VT;
    LAS float* SSX = (LAS float*)(L + GL_SSX);
    const int b = u / (GH * (SEQ / 64)), h = (u / (SEQ / 64)) % GH, c = u % (SEQ / 64);
    const int w = F.wave, eb = w >> 1, tt = w & 1, jl = F.lane & 31, hh = F.lane >> 5, tl = 32 * tt + jl;
    const size_t tok0 = (size_t)b * SEQ + c * 64;
    { const int t = F.tid >> 3, ch = F.tid & 7;
      const v4u qv = *(const GAS v4u*)(F.QB + (tok0 + t) * 256 + h * 64 + ch * 8), kv = *(const GAS v4u*)(F.KB + (tok0 + t) * 256 + h * 64 + ch * 8);
      v4u vv[2];
#pragma unroll
      for (int i = 0; i < 2; ++i) { const int cidx = F.tid + 512 * i; vv[i] = *(const GAS v4u*)((const unsigned char*)F.VB + vt_off(tok0, h, cidx >> 3, cidx & 7)); }
      *(LAS v4u*)(QD + t * GL_P + ch * 16) = qv; *(LAS v4u*)(KI + t * GL_P + ch * 16) = kv;
#pragma unroll
      for (int i = 0; i < 2; ++i) { const int cidx = F.tid + 512 * i; *(LAS v4u*)(VT + (cidx >> 3) * GL_P + (cidx & 7) * 16) = vv[i]; } }
    bf16x8 stf[4];
    { const bf16* sp = ST + ((size_t)u * 128 + 32 * eb + jl) * 64 + 8 * hh;
#pragma unroll
      for (int ks = 0; ks < 4; ++ks) stf[ks] = *(const GAS bf16x8*)(sp + 16 * ks); }
    const size_t tok = tok0 + tl;
    unsigned long long rw[4];
#pragma unroll
    for (int gq = 0; gq < 4; ++gq) rw[gq] = *(const GAS unsigned long long*)(F.RB + tok * 512 + h * 128 + 32 * eb + 8 * gq + 4 * hh);
    __syncthreads();
    bf16x8 qn[4];
#pragma unroll
    for (int ks = 0; ks < 4; ++ks) qn[ks] = *(const LAS bf16x8*)(QD + tl * GL_P + (2 * ks + hh) * 16);
    f32x16 X0, X1, O;
#pragma unroll
    for (int r = 0; r < 16; ++r) { X0[r] = 0.f; X1[r] = 0.f; O[r] = 0.f; }
#pragma unroll
    for (int ks = 0; ks < 4; ++ks) X0 = MFMA32(*(const LAS bf16x8*)(KI + jl * GL_P + (2 * ks + hh) * 16), qn[ks], X0);
    if (tt == 1) {
#pragma unroll
        for (int ks = 0; ks < 4; ++ks) X1 = MFMA32(*(const LAS bf16x8*)(KI + (32 + jl) * GL_P + (2 * ks + hh) * 16), qn[ks], X1);
#pragma unroll
        for (int r = 0; r < 16; ++r) if (crow(r, hh) > jl) X1[r] = 0.f;
    } else {
#pragma unroll
        for (int r = 0; r < 16; ++r) if (crow(r, hh) > jl) X0[r] = 0.f;
    }
#pragma unroll
    for (int ks = 0; ks < 4; ++ks) O = MFMA32(stf[ks], qn[ks], O);
    { const LAS unsigned char* vp = VT + (32 * eb + jl) * GL_P + 8 * hh;
      O = MFMA32(join8(*(const LAS s16x4*)(vp + 0), *(const LAS s16x4*)(vp + 16)), pack8<0>(X0), O);
      O = MFMA32(join8(*(const LAS s16x4*)(vp + 32), *(const LAS s16x4*)(vp + 48)), pack8<1>(X0), O);
      if (tt == 1) {
          O = MFMA32(join8(*(const LAS s16x4*)(vp + 64), *(const LAS s16x4*)(vp + 80)), pack8<0>(X1), O);
          O = MFMA32(join8(*(const LAS s16x4*)(vp + 96), *(const LAS s16x4*)(vp + 112)), pack8<1>(X1), O); } }
    float ss = 0.f;
#pragma unroll
    for (int r = 0; r < 16; ++r) ss += O[r] * O[r];
    ss += __shfl_xor(ss, 32);
    if (hh == 0) SSX[eb * 64 + tl] = ss;
    __syncthreads();
    const float rs = 1.f / sqrtf((SSX[tl] + SSX[64 + tl] + SSX[128 + tl] + SSX[192 + tl]) * (1.f / GDV) + EPS);
#pragma unroll
    for (int gq = 0; gq < 4; ++gq) { const int e = h * 128 + 32 * eb + 8 * gq + 4 * hh;
        const f32x4 g4 = *(const GAS f32x4*)(F.gla_g + 32 * eb + 8 * gq + 4 * hh);
        const unsigned rlo = (unsigned)rw[gq], rhi = (unsigned)(rw[gq] >> 32);
        const float y0 = O[4 * gq + 0] * rs * g4.x * pg8::bf_lo(rlo), y1 = O[4 * gq + 1] * rs * g4.y * pg8::bf_hi(rlo);
        const float y2 = O[4 * gq + 2] * rs * g4.z * pg8::bf_lo(rhi), y3 = O[4 * gq + 3] * rs * g4.w * pg8::bf_hi(rhi);
        *(GAS unsigned long long*)(F.HN + tok * D + 512 + e) = (unsigned long long)cvtpk(y0, y1) | ((unsigned long long)cvtpk(y2, y3) << 32); }
}
}


struct Args { const float* in[22]; float* out; unsigned char* ws; int ph_lo, ph_hi; };
__global__ void __launch_bounds__(NWAVES * 64, 2) mk_fwd(Args args) {
    extern __shared__ __attribute__((aligned(16))) unsigned char lds[];
    Frame F;
    F.lds = (LAS unsigned char*)lds;
    F.MISC = (volatile LAS unsigned*)(F.lds + MISC_OFF);
    F.tid = threadIdx.x; F.lane = F.tid & 63; F.wave = __builtin_amdgcn_readfirstlane(F.tid >> 6);
    F.G = gridDim.x; { const int bx = blockIdx.x; F.vcu = (F.G % 8 == 0) ? (bx % 8) * (F.G / 8) + bx / 8 : bx; }
    unsigned char* ws = args.ws;
    F.ctl = (gu32*)(ws + WS_CTL);
    F.x = args.in[0]; F.rel_bias = args.in[1]; F.f1_pre_g = args.in[2]; F.f1_wg = args.in[3]; F.f1_wu = args.in[4]; F.f1_wd = args.in[5]; F.f1_post_g = args.in[6];
    F.mix_pre_g = args.in[7]; F.w_in = args.in[8]; F.w_alpha = args.in[9]; F.b_alpha = args.in[10]; F.sinks = args.in[11]; F.gla_g = args.in[12];
    F.w_pa = args.in[13]; F.w_pb = args.in[14]; F.w_out = args.in[15]; F.mix_post_g = args.in[16];
    F.f2_pre_g = args.in[17]; F.f2_wg = args.in[18]; F.f2_wu = args.in[19]; F.f2_wd = args.in[20]; F.f2_post_g = args.in[21];
    F.out = args.out;
    F.W1GU = (bf16*)(ws + WS_W1GU); F.W1D = (bf16*)(ws + WS_W1D); F.W2GU = (bf16*)(ws + WS_W2GU); F.W2D = (bf16*)(ws + WS_W2D);
    F.WIN = (bf16*)(ws + WS_WIN); F.WPAB = (bf16*)(ws + WS_WPAB); F.WOUT = (bf16*)(ws + WS_WOUT);
    F.HN = (bf16*)(ws + WS_HN); F.FB = (bf16*)(ws + WS_F); F.HB = (bf16*)(ws + WS_BIG);
    F.QA = (bf16*)(ws + WS_QA); F.KV = (bf16*)(ws + WS_KV); F.QB = (bf16*)(ws + WS_QB); F.KB = (bf16*)(ws + WS_KB); F.VB = (bf16*)(ws + WS_VB); F.RB = (bf16*)(ws + WS_RB);
    F.GA = (bf16*)(ws + WS_GA); F.GB = (bf16*)(ws + WS_GB); F.MO = (bf16*)(ws + WS_MO);
    F.ALR = (float*)(ws + WS_ALR); F.OG = (float*)(ws + WS_F);
    for (int u = F.tid; u < (LDS_BYTES - LDSCTL_OFF) / 4; u += NWAVES * 64) ((LAS unsigned*)(F.lds + LDSCTL_OFF))[u] = 0u;
    __syncthreads();
    XcdBarrier bar; bar.bar = (unsigned*)(F.ctl + CW_BAR); bar.x = 0; bar.st = nullptr;
    if (N_LAUNCHES == 1) bar = xcd_barrier_post((unsigned*)(F.ctl + CW_BAR), F.MISC + 8);
#define GRID_BAR() do { if (N_LAUNCHES == 1) xcd_barrier(bar); } while (0)
    const int lo = args.ph_lo, hi = args.ph_hi;
#define IN(k) (lo <= (k) && (k) < hi)
#define SEAM(k) do { if (IN(k) && IN((k) + 1)) GRID_BAR(); } while (0)
    typedef pg8::bf16_t bt;

    if (IN(0)) { p0_prologue(F); } SEAM(0);
    if (IN(1)) { pg8::Gemm g{(const bt*)F.HN, (const bt*)F.W1GU, M, 2 * FF, D, D, D}; pg8::StaticOrder S; S.init(M, 2 * FF, F.G, (int)blockIdx.x);
        pg8::EpiSwiglu E{(bt*)F.HB, FF}; pg8::gemm_phase<pg8::EpiSwiglu, pg8::StaticOrder, true, true>(F.lds + RING_OFF, g, S, E); } SEAM(1);
    if (IN(2)) { pg8::Gemm g{(const bt*)F.HB, (const bt*)F.W1D, M, D, FF, FF, FF}; pg8::StaticOrder S; S.init(M, D, F.G, (int)blockIdx.x);
        pg8::EpiStore E{(bt*)F.FB, D}; pg8::gemm_phase<pg8::EpiStore, pg8::StaticOrder, true, true>(F.lds + RING_OFF, g, S, E); } SEAM(2);
    if (IN(3)) { thin_norm<true>(F, F.FB, F.x, F.out, 0.5f, F.f1_post_g, F.HN, F.mix_pre_g); } SEAM(3);
    if (IN(4)) { pg8::Gemm g{(const bt*)F.HN, (const bt*)F.WIN, M, NIN, D, D, D}; pg8::StaticOrder S; S.init(M, NIN, F.G, (int)blockIdx.x);
        pg8::EpiIn E{(bt*)F.QA, (bt*)F.KV, (bt*)F.QB, (bt*)F.KB, (bt*)F.VB, (bt*)F.RB, (bt*)F.GA, (bt*)F.GB, F.ALR, 0.125f * LOG2E, 0.125f};
        pg8::gemm_phase<pg8::EpiIn, pg8::StaticOrder, true, true>(F.lds + RING_OFF, g, S, E); } SEAM(4);
    if (IN(5)) {
#if FAST_GLA
        float* dST = (float*)(ws + WS_F); float* DECg = (float*)(ws + WS_DEC); bf16* ST = (bf16*)(ws + WS_ST);
        for (int u = blockIdx.x; u < mix::GLA_UNITS; u += F.G) mix::gla_pass_a(F, u, dST, DECg);
        mix::attn_bias_table(F); __syncthreads();
        for (int u = blockIdx.x; u < BATCH * NKVH * (SEQ / 64); u += F.G) mix::attn_unit(F, u / 64, (u / 32) & 1, u & 31);
        GRID_BAR();
        mix::gla_scan(F, dST, DECg, ST);
        GRID_BAR();
        for (int u = blockIdx.x; u < mix::GLA_UNITS; u += F.G) mix::gla_pass_c(F, u, ST);
#else
        gla_naive(F);
        __syncthreads();
        mix::attn_bias_table(F); __syncthreads();
        for (int u = blockIdx.x; u < BATCH * NKVH * (SEQ / 64); u += F.G) mix::attn_unit(F, u / 64, (u / 32) & 1, u & 31);
#endif
    } SEAM(5);
#if !FAST_GLA
    if (IN(6)) { gla_post(F); } SEAM(6);
#endif
    if (IN(7)) { pg8::Gemm g{(const bt*)F.HN, (const bt*)F.WPAB, M, D, 512, D, D}; pg8::StaticOrder S; S.init(M, D, F.G, (int)blockIdx.x);
        pg8::EpiGate<false> E{(const bt*)F.GA, (bt*)F.FB}; pg8::gemm_phase<pg8::EpiGate<false>, pg8::StaticOrder, true, true>(F.lds + RING_OFF, g, S, E); } SEAM(7);
    if (IN(8)) { pg8::Gemm g{(const bt*)F.HN + 512, (const bt*)F.WPAB + 512, M, D, 512, D, D}; pg8::StaticOrder S; S.init(M, D, F.G, (int)blockIdx.x);
        pg8::EpiGate<true> E{(const bt*)F.GB, (bt*)F.FB}; pg8::gemm_phase<pg8::EpiGate<true>, pg8::StaticOrder, true, true>(F.lds + RING_OFF, g, S, E); } SEAM(8);
    if (IN(9)) { pg8::Gemm g{(const bt*)F.FB, (const bt*)F.WOUT, M, D, D, D, D}; pg8::StaticOrder S; S.init(M, D, F.G, (int)blockIdx.x);
        pg8::EpiStore E{(bt*)F.MO, D}; pg8::gemm_phase<pg8::EpiStore, pg8::StaticOrder, true, true>(F.lds + RING_OFF, g, S, E); } SEAM(9);
    if (IN(10)) { thin_norm<true>(F, F.MO, F.out, F.out, 1.0f, F.mix_post_g, F.HN, F.f2_pre_g); } SEAM(10);
    if (IN(11)) { pg8::Gemm g{(const bt*)F.HN, (const bt*)F.W2GU, M, 2 * FF, D, D, D}; pg8::StaticOrder S; S.init(M, 2 * FF, F.G, (int)blockIdx.x);
        pg8::EpiSwiglu E{(bt*)F.HB, FF}; pg8::gemm_phase<pg8::EpiSwiglu, pg8::StaticOrder, true, true>(F.lds + RING_OFF, g, S, E); } SEAM(11);
    if (IN(12)) { pg8::Gemm g{(const bt*)F.HB, (const bt*)F.W2D, M, D, FF, FF, FF}; pg8::StaticOrder S; S.init(M, D, F.G, (int)blockIdx.x);
        pg8::EpiStore E{(bt*)F.FB, D}; pg8::gemm_phase<pg8::EpiStore, pg8::StaticOrder, true, true>(F.lds + RING_OFF, g, S, E); } SEAM(12);
    if (IN(13)) { thin_norm<false>(F, F.FB, F.out, F.out, 0.5f, F.f2_post_g, nullptr, nullptr); }
#undef IN
#undef SEAM
#undef GRID_BAR
}

extern "C" void kernel_launch(void* const* d_in, const int* in_sizes, int n_in, void* d_out, int out_size, void* d_ws, size_t ws_size, hipStream_t stream) {
    static int grid = 0;
    if (grid == 0) {
        if (n_in != 22 || in_sizes[0] != M * D || out_size != M * D || ws_size < WS_END || ws_size < WS_BIG + (size_t)M * FF * 2) {
            fprintf(stderr, "kernel_launch: shape/workspace mismatch: n_in %d in0 %d out %d ws %zu (need %zu)\n", n_in, n_in > 0 ? in_sizes[0] : -1, out_size, ws_size, (size_t)WS_END); grid = -1; return; }
        int dev = 0, cus = 0, per_cu = 0;
        if (hipGetDevice(&dev) != hipSuccess || hipDeviceGetAttribute(&cus, hipDeviceAttributeMultiprocessorCount, dev) != hipSuccess) { fprintf(stderr, "kernel_launch: device query failed\n"); grid = -1; return; }
        if (hipFuncSetAttribute((const void*)mk_fwd, hipFuncAttributeMaxDynamicSharedMemorySize, LDS_BYTES) != hipSuccess) { fprintf(stderr, "kernel_launch: hipFuncSetAttribute failed\n"); grid = -1; return; }
        if (hipOccupancyMaxActiveBlocksPerMultiprocessor(&per_cu, (const void*)mk_fwd, NWAVES * 64, LDS_BYTES) != hipSuccess || per_cu < 1)
            fprintf(stderr, "kernel_launch: note: occupancy query reports %d workgroups per CU\n", per_cu);
        (void)hipGetLastError();
        grid = cus;
    }
    if (grid < 0) return;
    if (hipMemsetAsync((char*)d_ws + WS_CTL, 0, CTL_ZERO_BYTES, stream) != hipSuccess) { fprintf(stderr, "kernel_launch: memset failed\n"); return; }
    Args a{};
    for (int i = 0; i < 22; ++i) a.in[i] = (const float*)d_in[i];
    a.out = (float*)d_out; a.ws = (unsigned char*)d_ws;
    for (int li = 0; li < N_LAUNCHES; ++li) {
        a.ph_lo = (N_LAUNCHES == 1) ? 0 : li; a.ph_hi = (N_LAUNCHES == 1) ? N_PHASES : li + 1;
        hipLaunchKernelGGL(mk_fwd, dim3(grid), dim3(NWAVES * 64), LDS_BYTES, stream, a);
        const hipError_t le = hipPeekAtLastError();
        if (le != hipSuccess) { fprintf(stderr, "kernel_launch: launch %d failed: %s\n", li, hipGetErrorName(le)); break; }
    }
}
```
